# Optimizing an MI355X kernel written in HIP

```python
import jax, jax.numpy as jnp
from jax import lax
import numpy as np

D_MODEL = 1024
BATCH = 8
SEQ = 2048
DEPTH = 1
DEC_BATCH = 128
DEC_SEQ = 1
PAST_LEN = 16384
PAGE_SIZE = 128

N_META = 16
POOL_WIDTH = D_MODEL // 2
POOL_WINDOWS = (2, 4, 8, 16)
POOL_GROUPS = len(POOL_WINDOWS)
POOL_GROUP = POOL_WIDTH // POOL_GROUPS
POOL_MAXW = max(POOL_WINDOWS)
POOL_BUF = POOL_MAXW - 1
HG_HEADS = 4
HG_WIDTH = D_MODEL // 2
HG_DK = 128
HG_DV = HG_WIDTH // HG_HEADS
HG_KTOT = HG_HEADS * HG_DK
HG_CHUNK = 64
D_FF = 4 * D_MODEL
EPS = 1e-6
SPLITS = (POOL_WIDTH, HG_KTOT, HG_KTOT, HG_WIDTH, HG_WIDTH, D_MODEL, D_MODEL)
N_IN = sum(SPLITS)

kernel_name = 'hybrid_pool_hgrn2_meta_decoder_step'


def _rmsnorm(x, g):
    xf = x.astype(jnp.float32)
    y = xf * lax.rsqrt(jnp.mean(xf * xf, axis=-1, keepdims=True) + EPS) * g.astype(jnp.float32)
    return y.astype(x.dtype)


def _pool_mix(u, pos):
    L = u.shape[1]
    cs = jnp.pad(jnp.cumsum(u, axis=1), ((0, 0), (POOL_MAXW, 0), (0, 0)))
    outs = []
    for gi, w in enumerate(POOL_WINDOWS):
        sl = slice(gi * POOL_GROUP, (gi + 1) * POOL_GROUP)
        wsum = cs[:, POOL_MAXW:, sl] - cs[:, POOL_MAXW - w:POOL_MAXW - w + L, sl]
        cnt = jnp.minimum(pos + 1, w).astype(jnp.float32)
        outs.append(wsum / cnt[None, :, None])
    return jnp.concatenate(outs, axis=-1) - u


def _hgrn_chunk(S0, q, k, v, g):
    C = q.shape[1]
    G = jnp.cumsum(g, axis=1)
    causal = jnp.tril(jnp.ones((C, C), dtype=bool))[None, :, :, None, None]
    diff = G[:, :, None] - G[:, None, :]
    decay = jnp.exp(jnp.where(causal, diff, -jnp.inf))
    A = jnp.einsum('bthk,btshk,bshk->bhts', q, decay, k)
    o = jnp.einsum('bhts,bshv->bthv', A, v) + jnp.einsum('bthk,bhkv->bthv', q * jnp.exp(G), S0)
    G_last = G[:, -1]
    S = jnp.exp(G_last)[..., None] * S0 + jnp.einsum('bshk,bshv->bhkv', k * jnp.exp(G_last[:, None] - G), v)
    return S, o


def _hgrn_scan(S0, q, k, v, g):
    B, L = q.shape[:2]
    n = L // HG_CHUNK

    def blk(a):
        return a.reshape(B, n, HG_CHUNK, *a.shape[2:]).swapaxes(0, 1)

    def step(S, inp):
        return _hgrn_chunk(S, *inp)

    S, o = lax.scan(step, S0, (blk(q), blk(k), blk(v), blk(g)))
    return S, o.swapaxes(0, 1).reshape(B, L, *o.shape[3:])


def _layer(x, pool_prev, S0, start_pos, prompt, lb, g_mix, w_in, w_pool, pool_scale,
           g_onorm, w_a, w_b, w_out, g_mlp, w_up, w_down):
    B, L, _ = x.shape
    f32 = jnp.float32
    h = _rmsnorm(x, g_mix)
    z = h @ w_in
    offs = [int(o) for o in np.cumsum(SPLITS)[:-1]]
    u, q, f, v, og, ga, gb = jnp.split(z, offs, axis=-1)
    u32 = u.astype(f32)
    if pool_prev is None:
        u_cat = u32
        pos = start_pos + jnp.arange(L)
    else:
        u_cat = jnp.concatenate([pool_prev.astype(f32), u32], axis=1)
        pos = start_pos - POOL_BUF + jnp.arange(POOL_BUF + L)
    pooled = _pool_mix(u_cat, pos)[:, -L:].reshape(B, L, POOL_GROUPS, POOL_GROUP)
    new_pool = u_cat[:, -POOL_BUF:].astype(x.dtype)
    ya = jnp.einsum('blgc,gcd->blgd', pooled, w_pool.astype(f32)).reshape(B, L, POOL_WIDTH)
    ya = (ya * pool_scale.astype(f32)).astype(x.dtype) @ w_a
    qh = jax.nn.silu(q.astype(f32)).reshape(B, L, HG_HEADS, HG_DK)
    fg = lb + (1.0 - lb) * jax.nn.sigmoid(f.astype(f32))
    kh = (1.0 - fg).reshape(B, L, HG_HEADS, HG_DK)
    gh = jnp.log(fg).reshape(B, L, HG_HEADS, HG_DK)
    vh = v.astype(f32).reshape(B, L, HG_HEADS, HG_DV)
    S0 = S0.astype(f32)
    if prompt:
        S, o_meta = _hgrn_chunk(S0, qh[:, :N_META], kh[:, :N_META], vh[:, :N_META], gh[:, :N_META])
        S, o_real = _hgrn_scan(S, qh[:, N_META:], kh[:, N_META:], vh[:, N_META:], gh[:, N_META:])
        o = jnp.concatenate([o_meta, o_real], axis=1)
    else:
        S, o = _hgrn_chunk(S0, qh, kh, vh, gh)
    o = _rmsnorm(o, g_onorm) * jax.nn.silu(og.astype(f32)).reshape(B, L, HG_HEADS, HG_DV)
    yb = o.reshape(B, L, HG_WIDTH).astype(x.dtype) @ w_b
    m = jax.nn.sigmoid(ga) * ya + jax.nn.sigmoid(gb) * yb
    x = x + m @ w_out
    h2 = _rmsnorm(x, g_mlp)
    x = x + jnp.square(jax.nn.relu(h2 @ w_up)) @ w_down
    return x, new_pool, S.astype(x.dtype)


def setup_inputs(seed: int = 0) -> dict:
    key = jax.random.key(seed)
    ks = jax.random.split(key, 20)
    nrm = jax.random.normal
    f32 = jnp.float32
    return {
        'x_prompt': nrm(ks[0], (BATCH, SEQ, D_MODEL), f32),
        'x_sample': nrm(ks[1], (DEC_BATCH, DEC_SEQ, D_MODEL), f32),
        'state_pool': nrm(ks[2], (DEPTH, DEC_BATCH, POOL_BUF, POOL_WIDTH), f32) * 0.5,
        'state_hgrn': nrm(ks[3], (DEPTH, DEC_BATCH, HG_HEADS, HG_DK, HG_DV), f32) * 0.5,
        'meta_tokens': nrm(ks[4], (N_META, D_MODEL), f32),
        'g_mix': 1.0 + 0.02 * nrm(ks[5], (DEPTH, D_MODEL), f32),
        'w_in': nrm(ks[6], (DEPTH, D_MODEL, N_IN), f32) * D_MODEL ** -0.5,
        'w_pool': nrm(ks[7], (DEPTH, POOL_GROUPS, POOL_GROUP, POOL_GROUP), f32) * POOL_GROUP ** -0.5,
        'pool_scale': 1.0 + 0.02 * nrm(ks[8], (DEPTH, POOL_WIDTH), f32),
        'hgrn_lb_logits': 0.5 * nrm(ks[9], (DEPTH + 1, HG_KTOT), f32),
        'g_onorm': 1.0 + 0.02 * nrm(ks[10], (DEPTH, HG_DV), f32),
        'w_a': nrm(ks[11], (DEPTH, POOL_WIDTH, D_MODEL), f32) * POOL_WIDTH ** -0.5,
        'w_b': nrm(ks[12], (DEPTH, HG_WIDTH, D_MODEL), f32) * HG_WIDTH ** -0.5,
        'w_out': nrm(ks[13], (DEPTH, D_MODEL, D_MODEL), f32) * D_MODEL ** -0.5,
        'g_mlp': 1.0 + 0.02 * nrm(ks[14], (DEPTH, D_MODEL), f32),
        'w_up': nrm(ks[15], (DEPTH, D_MODEL, D_FF), f32) * D_MODEL ** -0.5,
        'w_down': nrm(ks[16], (DEPTH, D_FF, D_MODEL), f32) * D_FF ** -0.5,
        'g_final': 1.0 + 0.02 * nrm(ks[17], (D_MODEL,), f32),
    }


def reference(x_prompt, x_sample, state_pool, state_hgrn, meta_tokens, g_mix, w_in, w_pool,
              pool_scale, hgrn_lb_logits, g_onorm, w_a, w_b, w_out, g_mlp, w_up, w_down, g_final):
    B = x_prompt.shape[0]
    lb_all = jnp.cumsum(jax.nn.softmax(hgrn_lb_logits.astype(jnp.float32), axis=0), axis=0)
    meta = jnp.broadcast_to(meta_tokens[None].astype(x_prompt.dtype), (B, N_META, D_MODEL))
    xp = jnp.concatenate([meta, x_prompt], axis=1)
    xs = x_sample
    pool_p, hgrn_p, pool_s, hgrn_s = [], [], [], []
    for l in range(DEPTH):
        params = (lb_all[l], g_mix[l], w_in[l], w_pool[l], pool_scale[l], g_onorm[l],
                  w_a[l], w_b[l], w_out[l], g_mlp[l], w_up[l], w_down[l])
        S_init = jnp.zeros((B, HG_HEADS, HG_DK, HG_DV), jnp.float32)
        xp, pp, sp = _layer(xp, None, S_init, 0, True, *params)
        xs, ps, ss = _layer(xs, state_pool[l], state_hgrn[l], PAST_LEN, False, *params)
        pool_p.append(pp)
        hgrn_p.append(sp)
        pool_s.append(ps)
        hgrn_s.append(ss)
    y_prompt = _rmsnorm(xp, g_final)[:, N_META:]
    y_sample = _rmsnorm(xs, g_final)
    new_pool_prompt = jnp.stack(pool_p)
    new_hgrn_prompt = jnp.stack(hgrn_p)
    new_pool_sample = jnp.stack(pool_s)
    new_hgrn_sample = jnp.stack(hgrn_s)
    return (y_prompt, y_sample, new_pool_prompt, new_hgrn_prompt, new_pool_sample, new_hgrn_sample)
```

```cpp
#include <hip/hip_runtime.h>
#include <hip/hip_cooperative_groups.h>
#include <cstdio>
#include <cstdint>
namespace cg = cooperative_groups;
namespace pg8 {
#define PG8_LAS __attribute__((address_space(3)))
typedef unsigned short bf16_t;
typedef short bf16x8 __attribute__((ext_vector_type(8)));
typedef float f32x4 __attribute__((ext_vector_type(4)));
typedef unsigned u32x4 __attribute__((ext_vector_type(4)));
constexpr int BM = 256, BK = 64, HALF = 128, HTB = HALF * BK * 2  , STAGE_BYTES = 8 * HTB, NXCD = 8, WGM = 8;

__host__ __device__ __forceinline__ int lds_byte(int r, int c) { const int st = (r >> 4) * 2 + (c >> 5), rr = r & 15, cc = c & 31, ob = rr * 64 + cc * 2; return st * 1024 + (ob ^ (((ob >> 9) & 1) << 5)); }
__host__ __device__ __forceinline__ void stage_rc(int b, int& R, int& C) { const int st = b / 1024, sb = b % 1024, swz = sb ^ (((sb >> 9) & 1) << 5); R = (st >> 1) * 16 + swz / 64; C = (st & 1) * 32 + (swz % 64) / 2; }
__host__ __device__ __forceinline__ int perm32(int rho) { const int n = rho >> 4, i = rho & 15; return 8 * (i >> 2) + 4 * n + (i & 3); }

struct Unit { int pm, pn; };
struct Gemm { const bf16_t* A; const bf16_t* Bt; int M, N, K; };

struct StaticOrder {
    int nM, nN, nwg, G, c;
    __host__ __device__ void init(int M, int N, int G_, int c_) { nM = M / BM; nN = N / BM; nwg = nM * nN; G = G_; c = c_; }
    __host__ __device__ bool next(int i, Unit& u) const {
        const long L = (long)i * G + c; if (L >= nwg) return false;
        int wgid = (int)L; { const int q = nwg / NXCD, r = nwg % NXCD, xcd = wgid % NXCD, off = wgid / NXCD; wgid = (xcd < r ? xcd * (q + 1) : r * (q + 1) + (xcd - r) * q) + off; }
        const int nig = WGM * nN, gid = wgid / nig, fm = gid * WGM, gsz = (nM - fm) < WGM ? (nM - fm) : WGM;
        u.pm = fm + ((wgid % nig) % gsz); u.pn = (wgid % nig) / gsz; return true;
    }
    __device__ __forceinline__ void a_ready(const Unit&) const {}
    __device__ __forceinline__ void done(const Unit&) const {}
};

__device__ __forceinline__ unsigned cvt_pk_bf16(float lo, float hi) { unsigned r; asm volatile("v_cvt_pk_bf16_f32 %0, %1, %2" : "=v"(r) : "v"(lo), "v"(hi)); return r; }
typedef float f32x2 __attribute__((ext_vector_type(2)));
template <class Epi, class Sched, bool ALIGN_EPI = false, bool SP2 = false>
__device__ __forceinline__ void gemm_phase(PG8_LAS unsigned char* lds, const Gemm g, const Sched& S, const Epi& E) {
    const int tid = threadIdx.x, wid = __builtin_amdgcn_readfirstlane(tid >> 6), lane = tid & 63, wr = wid >> 2, wc = wid & 3, fr = lane & 15, fq = lane >> 4;
    const int K = g.K, nt = K / BK;
    unsigned voffA[2], voffB[2];
#pragma unroll
    for (int i = 0; i < 2; ++i) { int R, C; stage_rc(tid * 16 + i * 8192, R, C); const int Rb = Epi::PERM ? ((R & ~31) + perm32(R & 31)) : R;
        voffA[i] = (unsigned)(R * K + C) * 2u; voffB[i] = (unsigned)(Rb * K + C) * 2u; }
    const size_t kstep = (size_t)(BK * 2);
    const size_t hstep = (size_t)HALF * K * 2;
    const size_t tstep = 2 * hstep;
    const unsigned ldsw = (unsigned)wid * 1024u;
    const int aoff = lds_byte(wr * 64 + fr, fq * 8), boff = lds_byte(wc * 32 + fr, fq * 8);
#define PG8_SA(b, h) (((b) * 2 + (h)) * HTB)
#define PG8_SB(b, h) ((4 + (b) * 2 + (h)) * HTB)
#define PG8_STAGE(bufoff, gbase, voff) do { _Pragma("unroll") for (int _i = 0; _i < 2; ++_i) \
        __builtin_amdgcn_global_load_lds((const unsigned*)((const char*)(gbase) + (voff)[_i]), (PG8_LAS unsigned*)(lds + (bufoff) + ldsw + _i * 8192), 16, 0, 0); } while (0)
#define PG8_LDA(dst, b, h) do { _Pragma("unroll") for (int m = 0; m < 4; ++m) _Pragma("unroll") for (int k = 0; k < 2; ++k) dst[m][k] = *(const PG8_LAS bf16x8*)(lds + PG8_SA(b, h) + aoff + m * 2048 + k * 1024); } while (0)
#define PG8_LDB(dst, b, h) do { _Pragma("unroll") for (int n = 0; n < 2; ++n) _Pragma("unroll") for (int k = 0; k < 2; ++k) dst[n][k] = *(const PG8_LAS bf16x8*)(lds + PG8_SB(b, h) + boff + n * 2048 + k * 1024); } while (0)
#define PG8_MMA(ai, bj, At, Bt) do { __builtin_amdgcn_s_setprio(1); _Pragma("unroll") for (int m = 0; m < 4; ++m) _Pragma("unroll") for (int n = 0; n < 2; ++n) _Pragma("unroll") for (int k = 0; k < 2; ++k) \
        acc[ai][bj][m][n] = __builtin_amdgcn_mfma_f32_16x16x32_bf16(Bt[n][k], At[m][k], acc[ai][bj][m][n], 0, 0, 0); __builtin_amdgcn_s_setprio(0); } while (0)
#define PG8_WAIT_V(n) asm volatile("s_waitcnt vmcnt(" #n ")" ::: "memory")
#define PG8_WAIT_L(n) asm volatile("s_waitcnt lgkmcnt(" #n ")" ::: "memory")
#define PG8_BAR __builtin_amdgcn_s_barrier()
#define PG8_SCHED __builtin_amdgcn_sched_barrier(0)
    Unit cur, nxt; int ui = 0;
    if (!S.next(0, cur)) return;
    f32x4 acc[2][2][4][2];
#pragma unroll
    for (int a = 0; a < 2; ++a)
#pragma unroll
        for (int b = 0; b < 2; ++b)
#pragma unroll
            for (int m = 0; m < 4; ++m)
#pragma unroll
                for (int n = 0; n < 2; ++n) acc[a][b][m][n] = (f32x4){0.f, 0.f, 0.f, 0.f};
    bf16x8 At[4][2], B0[2][2], B1[2][2];
    const char* cA = (const char*)g.A + (size_t)cur.pm * tstep; const char* cB = (const char*)g.Bt + (size_t)cur.pn * tstep;
    S.a_ready(cur);
    if constexpr (SP2) {
        PG8_STAGE(PG8_SB(0, 0), cB, voffB); PG8_STAGE(PG8_SB(0, 1), cB + hstep, voffB); PG8_STAGE(PG8_SA(0, 0), cA, voffA); PG8_STAGE(PG8_SA(0, 1), cA + hstep, voffA);
        if (wr == 1) PG8_BAR;
        PG8_WAIT_V(2); PG8_BAR;
        PG8_STAGE(PG8_SB(1, 0), cB + kstep, voffB); PG8_STAGE(PG8_SA(1, 0), cA + kstep, voffA); PG8_STAGE(PG8_SB(1, 1), cB + hstep + kstep, voffB);
        PG8_WAIT_V(6); PG8_BAR;
    } else {
        PG8_STAGE(PG8_SB(0, 0), cB, voffB); PG8_STAGE(PG8_SA(0, 0), cA, voffA); PG8_STAGE(PG8_SB(0, 1), cB + hstep, voffB); PG8_STAGE(PG8_SA(0, 1), cA + hstep, voffA);
        if (wr == 1) PG8_BAR;
        PG8_WAIT_V(4); PG8_BAR;
        PG8_STAGE(PG8_SB(1, 0), cB + kstep, voffB); PG8_STAGE(PG8_SA(1, 0), cA + kstep, voffA); PG8_STAGE(PG8_SB(1, 1), cB + hstep + kstep, voffB);
        PG8_WAIT_V(6); PG8_BAR;
    }
    for (;;) {
        const bool has_next = S.next(ui + 1, nxt);
        const char* nA = has_next ? (const char*)g.A + (size_t)nxt.pm * tstep : cA; const char* nB = has_next ? (const char*)g.Bt + (size_t)nxt.pn * tstep : cB;
        for (int t = 0; t < nt; t += 2) {
            const bool last = (t == nt - 2);
            const char* a1 = cA + (size_t)(t + 1) * kstep;
            const char* a2 = last ? nA : cA + (size_t)(t + 2) * kstep; const char* b2 = last ? nB : cB + (size_t)(t + 2) * kstep;
            const char* a3 = a2 + kstep; const char* b3 = b2 + kstep;
            if (last && has_next) S.a_ready(nxt);
            if constexpr (SP2) {
            PG8_LDB(B0, 0, 0); PG8_LDB(B1, 0, 1); PG8_SCHED; PG8_LDA(At, 0, 0); PG8_STAGE(PG8_SA(1, 1), a1 + hstep, voffA);
            PG8_WAIT_V(8); PG8_WAIT_L(0); PG8_BAR; PG8_MMA(0, 0, At, B0); PG8_MMA(0, 1, At, B1); PG8_BAR; PG8_SCHED;
            PG8_LDA(At, 0, 1); PG8_STAGE(PG8_SB(0, 0), b2, voffB); PG8_STAGE(PG8_SB(0, 1), b2 + hstep, voffB); PG8_STAGE(PG8_SA(0, 0), a2, voffA);
            PG8_WAIT_V(8); PG8_WAIT_L(0); PG8_BAR; PG8_MMA(1, 0, At, B0); PG8_MMA(1, 1, At, B1); PG8_BAR; PG8_SCHED;
            PG8_LDB(B0, 1, 0); PG8_LDB(B1, 1, 1); PG8_SCHED; PG8_LDA(At, 1, 0); PG8_STAGE(PG8_SA(0, 1), a2 + hstep, voffA);
            PG8_WAIT_V(8); PG8_WAIT_L(0); PG8_BAR; PG8_MMA(0, 0, At, B0); PG8_MMA(0, 1, At, B1); PG8_BAR; PG8_SCHED;
            PG8_LDA(At, 1, 1); PG8_STAGE(PG8_SB(1, 0), b3, voffB); PG8_STAGE(PG8_SB(1, 1), b3 + hstep, voffB); PG8_STAGE(PG8_SA(1, 0), a3, voffA);
            PG8_WAIT_V(8); PG8_WAIT_L(0); PG8_BAR; PG8_MMA(1, 0, At, B0); PG8_MMA(1, 1, At, B1); PG8_BAR; PG8_SCHED;
            } else {
            PG8_LDB(B0, 0, 0); PG8_SCHED; PG8_LDA(At, 0, 0); PG8_STAGE(PG8_SA(1, 1), a1 + hstep, voffA);
            PG8_WAIT_L(8); PG8_BAR; PG8_WAIT_L(0); PG8_MMA(0, 0, At, B0); PG8_BAR; PG8_SCHED;
            PG8_LDB(B1, 0, 1); PG8_STAGE(PG8_SB(0, 0), b2, voffB);
            PG8_BAR; PG8_WAIT_L(0); PG8_MMA(0, 1, At, B1); PG8_BAR;
            PG8_LDA(At, 0, 1); PG8_STAGE(PG8_SA(0, 0), a2, voffA);
            PG8_BAR; PG8_WAIT_L(0); PG8_MMA(1, 0, At, B0); PG8_BAR; PG8_SCHED;
            PG8_STAGE(PG8_SB(0, 1), b2 + hstep, voffB);
            PG8_WAIT_V(6); PG8_BAR; PG8_MMA(1, 1, At, B1); PG8_BAR;
            PG8_LDB(B0, 1, 0); PG8_SCHED; PG8_LDA(At, 1, 0); PG8_STAGE(PG8_SA(0, 1), a2 + hstep, voffA);
            PG8_WAIT_L(8); PG8_BAR; PG8_WAIT_L(0); PG8_MMA(0, 0, At, B0); PG8_BAR; PG8_SCHED;
            PG8_LDB(B1, 1, 1); PG8_STAGE(PG8_SB(1, 0), b3, voffB);
            PG8_BAR; PG8_WAIT_L(0); PG8_MMA(0, 1, At, B1); PG8_BAR;
            PG8_LDA(At, 1, 1); PG8_STAGE(PG8_SA(1, 0), a3, voffA);
            PG8_BAR; PG8_WAIT_L(0); PG8_MMA(1, 0, At, B0); PG8_BAR; PG8_SCHED;
            PG8_STAGE(PG8_SB(1, 1), b3 + hstep, voffB);
            PG8_WAIT_V(6); PG8_BAR; PG8_MMA(1, 1, At, B1); PG8_BAR;
            }
        }
        if constexpr (ALIGN_EPI) { if (wr == 0) PG8_BAR; }
        if constexpr (!Epi::AFTER_DRAIN) { E(acc, cur, wr, wc, fr, fq); S.done(cur); }
        if (!has_next) break;
#pragma unroll
        for (int a = 0; a < 2; ++a)
#pragma unroll
            for (int b = 0; b < 2; ++b)
#pragma unroll
                for (int m = 0; m < 4; ++m)
#pragma unroll
                    for (int n = 0; n < 2; ++n) acc[a][b][m][n] = (f32x4){0.f, 0.f, 0.f, 0.f};
        cur = nxt; cA = nA; cB = nB; ++ui;
        if constexpr (ALIGN_EPI) { if (wr == 1) PG8_BAR; }
    }
    PG8_WAIT_V(0);
    if constexpr (!ALIGN_EPI) { if (wr == 0) PG8_BAR; }
    PG8_BAR;
    if constexpr (Epi::AFTER_DRAIN) { E.fused(acc, cur, wr, wc, fr, fq, lds, wid, lane); S.done(cur); }
#undef PG8_SA
#undef PG8_SB
#undef PG8_STAGE
#undef PG8_LDA
#undef PG8_LDB
#undef PG8_MMA
#undef PG8_WAIT_V
#undef PG8_WAIT_L
#undef PG8_BAR
#undef PG8_SCHED
}
}

#define GAS __attribute__((address_space(1)))
#define LAS __attribute__((address_space(3)))
typedef unsigned short bf16;
typedef unsigned v4u __attribute__((ext_vector_type(4)));
typedef unsigned v2u __attribute__((ext_vector_type(2)));
typedef float f32x4 __attribute__((ext_vector_type(4)));
typedef short bf16x8 __attribute__((ext_vector_type(8)));
using pg8::Unit;

#ifndef MK_N_LAUNCHES
#define MK_N_LAUNCHES 1
#endif
constexpr int NPHASE = 10;
constexpr int NWAVES = 8, NTHR = 512;
constexpr int DM = 1024, NB = 8, SEQ = 2048, NMETA = 16, LP = SEQ + NMETA, NSAMP = 128;
constexpr int MP = NB * LP, M = MP + NSAMP, NMT = M / 256;
constexpr int NIN = 4608, FF = 4096, PW = 512;
constexpr int NCH = 33, PADT = 48, NBH = 32, NUNIT = NBH * NCH;
constexpr float EPS = 1e-6f;
constexpr int ZU = 0, ZQ = 512, ZF = 1024, ZV = 1536, ZOG = 2048, ZGA = 2560, ZGB = 3584;
constexpr size_t OUT_YP = 0, OUT_YS = (size_t)NB * SEQ * DM, OUT_NPP = OUT_YS + (size_t)NSAMP * DM, OUT_NHP = OUT_NPP + (size_t)NB * 15 * PW,
                 OUT_NPS = OUT_NHP + (size_t)NB * 4 * 16384, OUT_NHS = OUT_NPS + (size_t)NSAMP * 15 * PW, OUT_END = OUT_NHS + (size_t)NSAMP * 4 * 16384;
constexpr size_t MiB = 1u << 20;
constexpr size_t WS_LB = 0, WS_RSTD0 = 64 * 1024, WS_SS1 = 256 * 1024, WS_SS2 = 1536 * 1024, WS_DVEC = 3 * MiB, WS_XMETA = 4 * MiB, WS_DS0 = 5 * MiB;
constexpr size_t WS_WIN = 8 * MiB, WS_WAB = 17 * MiB, WS_WOUT = 19 * MiB, WS_WUP = 21 * MiB, WS_WDOWN = 29 * MiB;
constexpr size_t WS_RA = 37 * MiB;
constexpr size_t WS_RS = 70 * MiB;
constexpr size_t WS_Z = 103 * MiB;
constexpr size_t WS_END = 250 * MiB;
static_assert(WS_RA + (size_t)M * DM * 2 <= WS_RS && WS_RS + (size_t)NUNIT * 32768 <= WS_Z && WS_Z + (size_t)M * NIN * 2 <= WS_END, "ws map");
static_assert(WS_SS1 + 16 * (size_t)M * 4 <= WS_SS2 && WS_SS2 + 16 * (size_t)M * 4 <= WS_DVEC && WS_DVEC + (size_t)NUNIT * 512 <= WS_XMETA, "ws small map");
constexpr int LDS_BYTES = 147456;

#define LDS_WAIT() asm volatile("s_waitcnt lgkmcnt(0)" ::: "memory")
__device__ __forceinline__ unsigned f2bf(float f) { unsigned u = __builtin_bit_cast(unsigned, f); return (u + 0x7fffu + ((u >> 16) & 1u)) >> 16; }
__device__ __forceinline__ unsigned pk2(float lo, float hi) { return pg8::cvt_pk_bf16(lo, hi); }
__device__ __forceinline__ float bflo(unsigned u) { return __builtin_bit_cast(float, u << 16); }
__device__ __forceinline__ float bfhi(unsigned u) { return __builtin_bit_cast(float, u & 0xffff0000u); }
__device__ __forceinline__ float bf1(unsigned short u) { return __builtin_bit_cast(float, (unsigned)u << 16); }
__device__ __forceinline__ float h1(unsigned short u) { return (float)__builtin_bit_cast(_Float16, u); }
__device__ __forceinline__ unsigned pkh2(float lo, float hi) { const _Float16 a = (_Float16)lo, b = (_Float16)hi; return (unsigned)__builtin_bit_cast(unsigned short, a) | ((unsigned)__builtin_bit_cast(unsigned short, b) << 16); }
__device__ __forceinline__ float frcp(float x) { return __builtin_amdgcn_rcpf(x); }
__device__ __forceinline__ float sigm(float x) { return frcp(1.0f + __expf(-x)); }
__device__ __forceinline__ float wave_sum(float v) {
#pragma unroll
    for (int o = 1; o < 64; o <<= 1) v += __shfl_xor(v, o);
    return v;
}
__device__ __forceinline__ const float* xin_row(const float* xp, const float* xs, const float* meta, int r) {
    if (r >= MP) return xs + (size_t)(r - MP) * DM;
    const int b = r / LP, t = r - b * LP;
    return t < NMETA ? meta + (size_t)t * DM : xp + ((size_t)b * SEQ + (t - NMETA)) * DM;
}
__device__ __forceinline__ float* xsp_row(float* out, float* xmeta, int r) {
    if (r >= MP) return out + OUT_YS + (size_t)(r - MP) * DM;
    const int b = r / LP, t = r - b * LP;
    return t < NMETA ? xmeta + (size_t)(b * NMETA + t) * DM : out + ((size_t)b * SEQ + (t - NMETA)) * DM;
}

struct Epi1 {
    static constexpr bool PERM = true, AFTER_DRAIN = false;
    bf16* Z; const float* rstd0; const float* lb; float* out;
    __device__ __forceinline__ void operator()(const f32x4 (&acc)[2][2][4][2], const Unit& u, int wr, int wc, int fr, int fq) const {
        const int row0 = u.pm * 256 + wr * 64 + fr, colb = u.pn * 256 + wc * 32 + 8 * fq;
        const int type = u.pn < 10 ? (u.pn >> 1) : (u.pn < 14 ? 5 : 6);
#pragma unroll
        for (int ai = 0; ai < 2; ++ai)
#pragma unroll
            for (int m = 0; m < 4; ++m) {
                const int row = row0 + ai * 128 + m * 16; const float rs = rstd0[row];
                bf16* zr = Z + (size_t)row * NIN;
                float* pdst = nullptr;
                if (type == 0) { if (row >= MP) pdst = out + OUT_NPS + ((size_t)(row - MP) * 15 + 14) * PW; else { const int b = row / LP, t = row - b * LP; if (t >= LP - 15) pdst = out + OUT_NPP + ((size_t)b * 15 + (t - (LP - 15))) * PW; } }
#pragma unroll
                for (int bj = 0; bj < 2; ++bj) {
                    const int col = colb + bj * 128;
                    f32x4 v0 = acc[ai][bj][m][0] * rs, v1 = acc[ai][bj][m][1] * rs; v4u w;
                    if (type == 0 || type == 3) {
                        if (pdst) { *(f32x4*)(pdst + col) = v0; *(f32x4*)(pdst + col + 4) = v1; }
                        w.x = pk2(v0[0], v0[1]); w.y = pk2(v0[2], v0[3]); w.z = pk2(v1[0], v1[1]); w.w = pk2(v1[2], v1[3]);
                    } else if (type == 2) {
                        const f32x4 l0 = *(const f32x4*)(lb + col - ZF), l1 = *(const f32x4*)(lb + col - ZF + 4);
#pragma unroll
                        for (int e = 0; e < 4; ++e) { v0[e] = __logf(l0[e] + (1.0f - l0[e]) * sigm(v0[e])); v1[e] = __logf(l1[e] + (1.0f - l1[e]) * sigm(v1[e])); }
                        w.x = pkh2(v0[0], v0[1]); w.y = pkh2(v0[2], v0[3]); w.z = pkh2(v1[0], v1[1]); w.w = pkh2(v1[2], v1[3]);
                    } else {
#pragma unroll
                        for (int e = 0; e < 4; ++e) { const float s0 = sigm(v0[e]), s1 = sigm(v1[e]); v0[e] = type >= 5 ? s0 : v0[e] * s0; v1[e] = type >= 5 ? s1 : v1[e] * s1; }
                        w.x = pk2(v0[0], v0[1]); w.y = pk2(v0[2], v0[3]); w.z = pk2(v1[0], v1[1]); w.w = pk2(v1[2], v1[3]);
                    }
                    *(v4u*)(zr + col) = w;
                }
            }
    }
};
struct PairOrder {
    int G, c;
    __device__ bool next(int i, Unit& u) const { const int L = (i >> 1) * G + c; if (L >= NMT * 4) return false; const int half = i & 1; u.pm = (L >> 2) + half * NMT; u.pn = (L & 3) + half * 4; return true; }
    __device__ __forceinline__ void a_ready(const Unit&) const {}
    __device__ __forceinline__ void done(const Unit&) const {}
};
struct Epi2 {
    static constexpr bool PERM = false, AFTER_DRAIN = false;
    const bf16* Z; bf16* MB;
    __device__ __forceinline__ void operator()(const f32x4 (&acc)[2][2][4][2], const Unit& u, int wr, int wc, int fr, int fq) const {
        const int half = u.pm >= NMT ? 1 : 0;
        const int row0 = (u.pm - half * NMT) * 256 + wr * 64 + fr, colb = (u.pn - half * 4) * 256 + wc * 32 + 4 * fq;
        const int zoff = half ? ZGB : ZGA;
#pragma unroll
        for (int ai = 0; ai < 2; ++ai)
#pragma unroll
            for (int m = 0; m < 4; ++m) {
                const int row = row0 + ai * 128 + m * 16; const bf16* zr = Z + (size_t)row * NIN + zoff; bf16* mr = MB + (size_t)row * DM;
#pragma unroll
                for (int bj = 0; bj < 2; ++bj)
#pragma unroll
                    for (int n = 0; n < 2; ++n) {
                        const int col = colb + bj * 128 + n * 16;
                        const v2u g = *(const v2u*)(zr + col); const f32x4 a = acc[ai][bj][m][n];
                        float r0 = bflo(g.x) * a[0], r1 = bfhi(g.x) * a[1], r2 = bflo(g.y) * a[2], r3 = bfhi(g.y) * a[3];
                        if (half) { const v2u t = *(const v2u*)(mr + col); r0 += bflo(t.x); r1 += bfhi(t.x); r2 += bflo(t.y); r3 += bfhi(t.y); }
                        v2u o; o.x = pk2(r0, r1); o.y = pk2(r2, r3); *(v2u*)(mr + col) = o;
                    }
            }
    }
};
struct Epi3 {
    static constexpr bool PERM = false, AFTER_DRAIN = false;
    const float *xp, *xs, *meta; float* out; float* xmeta; bf16* X1B; float* SS;
    __device__ __forceinline__ void operator()(const f32x4 (&acc)[2][2][4][2], const Unit& u, int wr, int wc, int fr, int fq) const {
        const int row0 = u.pm * 256 + wr * 64 + fr, colb = u.pn * 256 + wc * 32 + 4 * fq;
#pragma unroll
        for (int ai = 0; ai < 2; ++ai)
#pragma unroll
            for (int m = 0; m < 4; ++m) {
                const int row = row0 + ai * 128 + m * 16; const float* xi = xin_row(xp, xs, meta, row); float* xo = xsp_row(out, xmeta, row); bf16* xb = X1B + (size_t)row * DM;
                float s = 0.f;
#pragma unroll
                for (int bj = 0; bj < 2; ++bj)
#pragma unroll
                    for (int n = 0; n < 2; ++n) {
                        const int col = colb + bj * 128 + n * 16;
                        const f32x4 v = *(const f32x4*)(xi + col) + acc[ai][bj][m][n];
                        *(f32x4*)(xo + col) = v; s += (v[0] * v[0] + v[1] * v[1]) + (v[2] * v[2] + v[3] * v[3]);
                        v2u o; o.x = pk2(v[0], v[1]); o.y = pk2(v[2], v[3]); *(v2u*)(xb + col) = o;
                    }
                s += __shfl_xor(s, 16); s += __shfl_xor(s, 32);
                if (fq == 0) SS[(size_t)(u.pn * 4 + wc) * M + row] = s;
            }
    }
};
__device__ __forceinline__ float rstd_from_parts(const float* SS, int row) {
    float s = 0.f;
#pragma unroll
    for (int p = 0; p < 16; ++p) s += SS[(size_t)p * M + row];
    return __builtin_amdgcn_rsqf(s * (1.0f / DM) + EPS);
}
struct Epi4 {
    static constexpr bool PERM = true, AFTER_DRAIN = false;
    bf16* AB; const float* SS;
    __device__ __forceinline__ void operator()(const f32x4 (&acc)[2][2][4][2], const Unit& u, int wr, int wc, int fr, int fq) const {
        const int row0 = u.pm * 256 + wr * 64 + fr, colb = u.pn * 256 + wc * 32 + 8 * fq;
#pragma unroll
        for (int ai = 0; ai < 2; ++ai)
#pragma unroll
            for (int m = 0; m < 4; ++m) {
                const int row = row0 + ai * 128 + m * 16; const float rs = rstd_from_parts(SS, row); bf16* ar = AB + (size_t)row * FF;
#pragma unroll
                for (int bj = 0; bj < 2; ++bj) {
                    f32x4 v0 = acc[ai][bj][m][0] * rs, v1 = acc[ai][bj][m][1] * rs;
#pragma unroll
                    for (int e = 0; e < 4; ++e) { const float a = fmaxf(v0[e], 0.f), b = fmaxf(v1[e], 0.f); v0[e] = a * a; v1[e] = b * b; }
                    v4u w; w.x = pk2(v0[0], v0[1]); w.y = pk2(v0[2], v0[3]); w.z = pk2(v1[0], v1[1]); w.w = pk2(v1[2], v1[3]);
                    *(v4u*)(ar + colb + bj * 128) = w;
                }
            }
    }
};
struct Epi5 {
    static constexpr bool PERM = false, AFTER_DRAIN = false;
    float* out; float* xmeta; float* SS;
    __device__ __forceinline__ void operator()(const f32x4 (&acc)[2][2][4][2], const Unit& u, int wr, int wc, int fr, int fq) const {
        const int row0 = u.pm * 256 + wr * 64 + fr, colb = u.pn * 256 + wc * 32 + 4 * fq;
#pragma unroll
        for (int ai = 0; ai < 2; ++ai)
#pragma unroll
            for (int m = 0; m < 4; ++m) {
                const int row = row0 + ai * 128 + m * 16; float* xo = xsp_row(out, xmeta, row);
                float s = 0.f;
#pragma unroll
                for (int bj = 0; bj < 2; ++bj)
#pragma unroll
                    for (int n = 0; n < 2; ++n) {
                        const int col = colb + bj * 128 + n * 16;
                        const f32x4 v = *(const f32x4*)(xo + col) + acc[ai][bj][m][n];
                        *(f32x4*)(xo + col) = v; s += (v[0] * v[0] + v[1] * v[1]) + (v[2] * v[2] + v[3] * v[3]);
                    }
                s += __shfl_xor(s, 16); s += __shfl_xor(s, 32);
                if (fq == 0) SS[(size_t)(u.pn * 4 + wc) * M + row] = s;
            }
    }
};

__device__ __forceinline__ void p0_transpose_item(const float* W, const float* rsc, int K, int N, bf16* WT, int row_off, LAS float* scr, int item, int lane) {
    const int nblk = N / 32, kb = item / nblk, nb = item % nblk, k0 = 64 * kb, n0 = 32 * nb;
#pragma unroll 8
    for (int i = 0; i < 32; ++i) { const int kk = 2 * i + (lane >> 5); float w = W[(size_t)(k0 + kk) * N + n0 + (lane & 31)]; if (rsc) w *= rsc[k0 + kk]; scr[kk * 33 + (lane & 31)] = w; }
    LDS_WAIT(); asm volatile("" ::: "memory");
    const int c = lane & 7;
#pragma unroll
    for (int j = 0; j < 4; ++j) { const int n = (lane >> 3) + 8 * j; const LAS float* s = scr + (8 * c) * 33 + n;
        v4u o; o.x = pk2(s[0 * 33], s[1 * 33]); o.y = pk2(s[2 * 33], s[3 * 33]); o.z = pk2(s[4 * 33], s[5 * 33]); o.w = pk2(s[6 * 33], s[7 * 33]);
        *(v4u*)(WT + (size_t)(row_off + n0 + n) * K + k0 + 8 * c) = o; }
    LDS_WAIT(); asm volatile("" ::: "memory");
}
__device__ __forceinline__ void p0_fold_item(const float* w_pool, const float* ps, const float* w_a, bf16* WT, int item, int lane) {
    const int g = item >> 8, rem = item & 255, c0 = (rem >> 4) * 8, n0 = (rem & 15) * 64;
    float a0 = 0.f, a1 = 0.f, a2 = 0.f, a3 = 0.f, a4 = 0.f, a5 = 0.f, a6 = 0.f, a7 = 0.f;
    const float* wp = w_pool + ((size_t)g * 128 + c0) * 128;
    for (int d = 0; d < 128; ++d) {
        const float wa = w_a[(size_t)(g * 128 + d) * DM + n0 + lane] * ps[g * 128 + d];
        a0 += wp[d] * wa; a1 += wp[128 + d] * wa; a2 += wp[256 + d] * wa; a3 += wp[384 + d] * wa;
        a4 += wp[512 + d] * wa; a5 += wp[640 + d] * wa; a6 += wp[768 + d] * wa; a7 += wp[896 + d] * wa;
    }
    v4u o; o.x = pk2(a0, a1); o.y = pk2(a2, a3); o.z = pk2(a4, a5); o.w = pk2(a6, a7);
    *(v4u*)(WT + (size_t)(n0 + lane) * PW + g * 128 + c0) = o;
}

#define SCAN_LOAD_G(gv, valid, zbase) do { _Pragma("unroll") for (int jj = 0; jj < 16; ++jj) gv[jj] = (valid) ? h1((zbase)[(size_t)jj * NIN]) : 0.f; } while (0)

__device__ __forceinline__ void scan_pass1_unit(LAS unsigned char* lds, const bf16* Z, float* dS, float* dv, int b, int h, int c, int tid) {
    LAS unsigned char* VT = lds; LAS unsigned char* KT = lds + 18432; LAS float* GP = (LAS float*)(lds + 36864);
    const int k = tid & 127, part = tid >> 7, wid = tid >> 6, lane = tid & 63, r = lane & 15, q = lane >> 4;
    const int t0 = c * 64 - PADT;
    const bool valid = (c > 0) || (part == 3);
    const long rowbase = (long)b * LP + t0;
    float gv[16];
    { const bf16* zg = Z + (rowbase + part * 16) * NIN + ZF + h * 128 + k; SCAN_LOAD_G(gv, valid, zg); }
    float G[16]; G[0] = gv[0];
#pragma unroll
    for (int jj = 1; jj < 16; ++jj) G[jj] = G[jj - 1] + gv[jj];
    GP[part * 128 + k] = G[15];
#pragma unroll
    for (int i = 0; i < 2; ++i) { const int idx = tid + 512 * i, j = idx >> 4, v8 = idx & 15; v4u w = (v4u){0u, 0u, 0u, 0u};
        if (c > 0 || j >= PADT) w = *(const v4u*)(Z + (rowbase + j) * NIN + ZV + h * 128 + v8 * 8);
        LAS unsigned short* d = (LAS unsigned short*)VT + (v8 * 8) * 72 + j;
        d[0] = (unsigned short)w.x; d[72] = (unsigned short)(w.x >> 16); d[144] = (unsigned short)w.y; d[216] = (unsigned short)(w.y >> 16);
        d[288] = (unsigned short)w.z; d[360] = (unsigned short)(w.z >> 16); d[432] = (unsigned short)w.w; d[504] = (unsigned short)(w.w >> 16); }
    __syncthreads();
    float off = 0.f, tot = 0.f;
#pragma unroll
    for (int p = 0; p < 4; ++p) { const float x = GP[p * 128 + k]; tot += x; if (p < part) off += x; }
    { unsigned w[8];
#pragma unroll
      for (int jj = 0; jj < 16; jj += 2) {
          const float k0 = valid ? (1.0f - __expf(gv[jj])) * __expf(tot - (off + G[jj])) : 0.f;
          const float k1 = valid ? (1.0f - __expf(gv[jj + 1])) * __expf(tot - (off + G[jj + 1])) : 0.f;
          w[jj >> 1] = pk2(k0, k1); }
      LAS v4u* d = (LAS v4u*)(KT + (k * 72 + part * 16) * 2);
      d[0] = (v4u){w[0], w[1], w[2], w[3]}; d[1] = (v4u){w[4], w[5], w[6], w[7]}; }
    if (part == 0) dv[k] = __expf(tot);
    __syncthreads();
    bf16x8 a0 = *(const LAS bf16x8*)(VT + ((16 * wid + r) * 72 + 8 * q) * 2), a1 = *(const LAS bf16x8*)(VT + ((16 * wid + r) * 72 + 8 * q + 32) * 2);
#pragma unroll
    for (int nb = 0; nb < 8; ++nb) {
        const bf16x8 b0 = *(const LAS bf16x8*)(KT + ((16 * nb + r) * 72 + 8 * q) * 2), b1 = *(const LAS bf16x8*)(KT + ((16 * nb + r) * 72 + 8 * q + 32) * 2);
        f32x4 acc = (f32x4){0.f, 0.f, 0.f, 0.f};
        acc = __builtin_amdgcn_mfma_f32_16x16x32_bf16(a0, b0, acc, 0, 0, 0);
        acc = __builtin_amdgcn_mfma_f32_16x16x32_bf16(a1, b1, acc, 0, 0, 0);
#pragma unroll
        for (int i = 0; i < 4; ++i) dS[(16 * wid + 4 * q + i) * 128 + 16 * nb + r] = acc[i];
    }
    __syncthreads();
}

__device__ __forceinline__ void scan_pass3_unit(LAS unsigned char* lds, const bf16* Z, const bf16* St, const float* g_onorm, bf16* ON, int b, int h, int c, int tid) {
    LAS unsigned char* Q1 = lds; LAS unsigned char* KT = lds + 17408; LAS unsigned char* SP = lds + 34816; LAS unsigned char* VT = lds + 69632; LAS unsigned char* A1 = lds + 88064;
    LAS float* GP = (LAS float*)(lds + 97280); LAS float* GR = (LAS float*)(lds + 99328); LAS float* SSX = (LAS float*)(lds + 99840);
    const int k = tid & 127, part = tid >> 7, wid = tid >> 6, lane = tid & 63, r = lane & 15, q = lane >> 4;
    const int t0 = c * 64 - PADT;
    const bool valid = (c > 0) || (part == 3);
    const long rowbase = (long)b * LP + t0;
    float gv[16];
    { const bf16* zg = Z + (rowbase + part * 16) * NIN + ZF + h * 128 + k; SCAN_LOAD_G(gv, valid, zg); }
    float G[16]; G[0] = gv[0];
#pragma unroll
    for (int jj = 1; jj < 16; ++jj) G[jj] = G[jj - 1] + gv[jj];
    GP[part * 128 + k] = G[15];
#pragma unroll
    for (int i = 0; i < 2; ++i) { const int idx = tid + 512 * i, j = idx >> 4, v8 = idx & 15; v4u w = (v4u){0u, 0u, 0u, 0u};
        if (c > 0 || j >= PADT) w = *(const v4u*)(Z + (rowbase + j) * NIN + ZV + h * 128 + v8 * 8);
        LAS unsigned short* d = (LAS unsigned short*)VT + (v8 * 8) * 72 + j;
        d[0] = (unsigned short)w.x; d[72] = (unsigned short)(w.x >> 16); d[144] = (unsigned short)w.y; d[216] = (unsigned short)(w.y >> 16);
        d[288] = (unsigned short)w.z; d[360] = (unsigned short)(w.z >> 16); d[432] = (unsigned short)w.w; d[504] = (unsigned short)(w.w >> 16); }
    __syncthreads();
    float off = 0.f;
#pragma unroll
    for (int p = 0; p < 4; ++p) { const float x = GP[p * 128 + k]; if (p < part) off += x; }
    const float gref = GP[k] + GP[128 + k];
    if (part == 0) GR[k] = __expf(gref);
    { const bf16* zq = Z + (rowbase + part * 16) * NIN + ZQ + h * 128 + k;
#pragma unroll
      for (int jj = 0; jj < 16; ++jj) {
          const float Gj = off + G[jj];
          const float qv = valid ? bf1(zq[(size_t)jj * NIN]) * __expf(Gj - gref) : 0.f;
          const float kv = valid ? (1.0f - __expf(gv[jj])) * __expf(gref - Gj) : 0.f;
          const int j = part * 16 + jj;
          ((LAS unsigned short*)Q1)[j * 136 + k] = (unsigned short)f2bf(qv);
          ((LAS unsigned short*)KT)[j * 136 + k] = (unsigned short)f2bf(kv);
      } }
    __syncthreads();
#pragma unroll
    for (int i = 0; i < 4; ++i) { const int idx = tid + 512 * i, v = idx >> 4, k8 = idx & 15;
        const v4u w = *(const v4u*)(St + (size_t)v * 128 + k8 * 8); const LAS float* gr = GR + k8 * 8;
        v4u o; o.x = pk2(bflo(w.x) * gr[0], bfhi(w.x) * gr[1]); o.y = pk2(bflo(w.y) * gr[2], bfhi(w.y) * gr[3]); o.z = pk2(bflo(w.z) * gr[4], bfhi(w.z) * gr[5]); o.w = pk2(bflo(w.w) * gr[6], bfhi(w.w) * gr[7]);
        *(LAS v4u*)(SP + (v * 136 + k8 * 8) * 2) = o; }
    { const int tb = wid >> 1;
      bf16x8 a[4];
#pragma unroll
      for (int ks = 0; ks < 4; ++ks) a[ks] = *(const LAS bf16x8*)(Q1 + ((16 * tb + r) * 136 + 8 * q + 32 * ks) * 2);
#pragma unroll
      for (int s2 = 0; s2 < 2; ++s2) { const int sb = 2 * (wid & 1) + s2; f32x4 acc = (f32x4){0.f, 0.f, 0.f, 0.f};
          if (sb <= tb) {
#pragma unroll
              for (int ks = 0; ks < 4; ++ks) { const bf16x8 bb = *(const LAS bf16x8*)(KT + ((16 * sb + r) * 136 + 8 * q + 32 * ks) * 2); acc = __builtin_amdgcn_mfma_f32_16x16x32_bf16(a[ks], bb, acc, 0, 0, 0); }
          }
#pragma unroll
          for (int i = 0; i < 4; ++i) { const int t = 16 * tb + 4 * q + i, s = 16 * sb + r; ((LAS unsigned short*)A1)[t * 72 + s] = (unsigned short)f2bf(s <= t ? acc[i] : 0.f); }
      } }
    __syncthreads();
    const int tb = wid & 3, vb0 = 4 * (wid >> 2);
    f32x4 o[4];
    { bf16x8 a1[2], aq[4];
#pragma unroll
      for (int ks = 0; ks < 2; ++ks) a1[ks] = *(const LAS bf16x8*)(A1 + ((16 * tb + r) * 72 + 8 * q + 32 * ks) * 2);
#pragma unroll
      for (int ks = 0; ks < 4; ++ks) aq[ks] = *(const LAS bf16x8*)(Q1 + ((16 * tb + r) * 136 + 8 * q + 32 * ks) * 2);
#pragma unroll
      for (int vi = 0; vi < 4; ++vi) { const int vb = vb0 + vi; f32x4 acc = (f32x4){0.f, 0.f, 0.f, 0.f};
#pragma unroll
          for (int ks = 0; ks < 2; ++ks) { const bf16x8 bb = *(const LAS bf16x8*)(VT + ((16 * vb + r) * 72 + 8 * q + 32 * ks) * 2); acc = __builtin_amdgcn_mfma_f32_16x16x32_bf16(a1[ks], bb, acc, 0, 0, 0); }
#pragma unroll
          for (int ks = 0; ks < 4; ++ks) { const bf16x8 bb = *(const LAS bf16x8*)(SP + ((16 * vb + r) * 136 + 8 * q + 32 * ks) * 2); acc = __builtin_amdgcn_mfma_f32_16x16x32_bf16(aq[ks], bb, acc, 0, 0, 0); }
          o[vi] = acc; } }
    float ss[4];
#pragma unroll
    for (int i = 0; i < 4; ++i) { float s = (o[0][i] * o[0][i] + o[1][i] * o[1][i]) + (o[2][i] * o[2][i] + o[3][i] * o[3][i]);
        s += __shfl_xor(s, 1); s += __shfl_xor(s, 2); s += __shfl_xor(s, 4); s += __shfl_xor(s, 8); ss[i] = s; }
    if (r == 0) {
#pragma unroll
        for (int i = 0; i < 4; ++i) SSX[(16 * tb + 4 * q + i) * 2 + (wid >> 2)] = ss[i]; }
    __syncthreads();
#pragma unroll
    for (int i = 0; i < 4; ++i) { const int t = 16 * tb + 4 * q + i; const float rstd = __builtin_amdgcn_rsqf((SSX[t * 2] + SSX[t * 2 + 1]) * (1.0f / 128.0f) + EPS);
        if (c > 0 || t >= PADT) { const size_t row = rowbase + t;
#pragma unroll
            for (int vi = 0; vi < 4; ++vi) { const int vc = 16 * (vb0 + vi) + r; const float og = bf1(Z[row * NIN + ZOG + h * 128 + vc]);
                ON[row * PW + h * 128 + vc] = (bf16)f2bf(o[vi][i] * rstd * g_onorm[vc] * og); } } }
    __syncthreads();
}

__device__ __forceinline__ void sample_hgrn_unit(LAS unsigned char* lds, const bf16* Z, const float* S0, float* Sout, const float* g_onorm, bf16* ON, int s, int h, int tid) {
    LAS float* OP = (LAS float*)lds;
    const size_t row = (size_t)MP + s; const bf16* zr = Z + row * NIN;
    const int v4 = tid & 31, kb = tid >> 5;
    const v2u vw = *(const v2u*)(zr + ZV + h * 128 + v4 * 4); const f32x4 vv = (f32x4){bflo(vw.x), bfhi(vw.x), bflo(vw.y), bfhi(vw.y)};
    f32x4 o4 = (f32x4){0.f, 0.f, 0.f, 0.f};
    const size_t sb = ((size_t)(s * 4 + h) * 128) * 128 + v4 * 4;
#pragma unroll
    for (int i = 0; i < 8; ++i) { const int k = kb + 16 * i; const float f = __expf(h1(zr[ZF + h * 128 + k])), kk = 1.0f - f, qk = bf1(zr[ZQ + h * 128 + k]);
        const f32x4 sn = *(const f32x4*)(S0 + sb + (size_t)k * 128) * f + vv * kk; *(f32x4*)(Sout + sb + (size_t)k * 128) = sn; o4 += sn * qk; }
    *(LAS f32x4*)(OP + kb * 128 + v4 * 4) = o4;
    __syncthreads();
    if (tid < 64) { float oa = 0.f, ob = 0.f;
#pragma unroll
        for (int p = 0; p < 16; ++p) { oa += OP[p * 128 + tid]; ob += OP[p * 128 + 64 + tid]; }
        const float rstd = __builtin_amdgcn_rsqf(wave_sum(oa * oa + ob * ob) * (1.0f / 128.0f) + EPS);
        ON[row * PW + h * 128 + tid] = (bf16)f2bf(oa * rstd * g_onorm[tid] * bf1(zr[ZOG + h * 128 + tid]));
        ON[row * PW + h * 128 + 64 + tid] = (bf16)f2bf(ob * rstd * g_onorm[64 + tid] * bf1(zr[ZOG + h * 128 + 64 + tid])); }
    __syncthreads();
}

struct Args { const float* in[18]; float* out; unsigned char* ws; int ph_lo, ph_hi; };
__global__ void __launch_bounds__(NTHR, 2) hybrid_fwd(Args args) {
    extern __shared__ __attribute__((aligned(16))) unsigned char lds_raw[];
    LAS unsigned char* lds = (LAS unsigned char*)lds_raw;
    const int tid = threadIdx.x, lane = tid & 63, wave = __builtin_amdgcn_readfirstlane(tid >> 6);
    const int G = gridDim.x, bx = blockIdx.x;
    const int gw = bx * NWAVES + wave, NGW = G * NWAVES;
    const int gt = bx * NTHR + tid, NGT = G * NTHR;
    unsigned char* ws = args.ws; float* out = args.out;
    const float *x_prompt = args.in[0], *x_sample = args.in[1], *state_pool = args.in[2], *state_hgrn = args.in[3], *meta = args.in[4], *g_mix = args.in[5], *w_in = args.in[6],
                *w_pool = args.in[7], *pool_scale = args.in[8], *lb_logits = args.in[9], *g_onorm = args.in[10], *w_a = args.in[11], *w_b = args.in[12], *w_out = args.in[13],
                *g_mlp = args.in[14], *w_up = args.in[15], *w_down = args.in[16], *g_final = args.in[17];
    float* LB = (float*)(ws + WS_LB); float* RSTD0 = (float*)(ws + WS_RSTD0); float* SS1 = (float*)(ws + WS_SS1); float* SS2 = (float*)(ws + WS_SS2);
    float* DVEC = (float*)(ws + WS_DVEC); float* XMETA = (float*)(ws + WS_XMETA); float* DS0 = (float*)(ws + WS_DS0);
    bf16 *WIN = (bf16*)(ws + WS_WIN), *WAB = (bf16*)(ws + WS_WAB), *WOUT = (bf16*)(ws + WS_WOUT), *WUP = (bf16*)(ws + WS_WUP), *WDOWN = (bf16*)(ws + WS_WDOWN);
    bf16 *XB = (bf16*)(ws + WS_RA), *PO = (bf16*)(ws + WS_RA), *ON = PO + (size_t)M * PW, *X1B = (bf16*)(ws + WS_RA);
    bf16 *ST = (bf16*)(ws + WS_RS), *MB = (bf16*)(ws + WS_RS);
    bf16 *Z = (bf16*)(ws + WS_Z), *AB = (bf16*)(ws + WS_Z);
    const int lo = args.ph_lo, hi = args.ph_hi;
#define IN(k) (lo <= (k) && (k) < hi)
#define SEAM(k) do { if (IN(k) && IN((k) + 1)) cg::this_grid().sync(); } while (0)

    if (IN(0)) {
        LAS float* scr = (LAS float*)(lds + wave * 16384);
        if (gt < PW) LB[gt] = frcp(1.0f + __expf(lb_logits[PW + gt] - lb_logits[gt]));
        constexpr int I_IN = (DM / 64) * (NIN / 32), I_B = (PW / 64) * (DM / 32), I_O = (DM / 64) * (DM / 32), I_UP = (DM / 64) * (FF / 32), I_DN = (FF / 64) * (DM / 32), I_FOLD = 1024;
        constexpr int NITEMS = I_IN + I_B + I_O + I_UP + I_DN + I_FOLD;
        for (int it = gw; it < NITEMS; it += NGW) {
            int r = it;
            if (r < I_IN) { p0_transpose_item(w_in, g_mix, DM, NIN, WIN, 0, scr, r, lane); continue; } r -= I_IN;
            if (r < I_B) { p0_transpose_item(w_b, nullptr, PW, DM, WAB, DM, scr, r, lane); continue; } r -= I_B;
            if (r < I_O) { p0_transpose_item(w_out, nullptr, DM, DM, WOUT, 0, scr, r, lane); continue; } r -= I_O;
            if (r < I_UP) { p0_transpose_item(w_up, g_mlp, DM, FF, WUP, 0, scr, r, lane); continue; } r -= I_UP;
            if (r < I_DN) { p0_transpose_item(w_down, nullptr, FF, DM, WDOWN, 0, scr, r, lane); continue; } r -= I_DN;
            p0_fold_item(w_pool, pool_scale, w_a, WAB, r, lane);
        }
        for (int m = gw; m < M; m += NGW) {
            const f32x4* xr = (const f32x4*)xin_row(x_prompt, x_sample, meta, m) + lane; f32x4 v[4]; float s = 0.f;
#pragma unroll
            for (int j = 0; j < 4; ++j) { v[j] = xr[64 * j]; s += (v[j][0] * v[j][0] + v[j][1] * v[j][1]) + (v[j][2] * v[j][2] + v[j][3] * v[j][3]); }
            s = wave_sum(s); if (lane == 0) RSTD0[m] = __builtin_amdgcn_rsqf(s * (1.0f / DM) + EPS);
            v2u* o8 = (v2u*)(XB + (size_t)m * DM) + lane;
#pragma unroll
            for (int j = 0; j < 4; ++j) { v2u o; o.x = pk2(v[j][0], v[j][1]); o.y = pk2(v[j][2], v[j][3]); o8[64 * j] = o; }
        }
        for (int i = gt; i < NSAMP * 14 * (PW / 4); i += NGT) {
            const int s = i / (14 * 128), rem = i - s * (14 * 128), j = rem >> 7, c4 = rem & 127;
            *(f32x4*)(out + OUT_NPS + ((size_t)s * 15 + j) * PW + c4 * 4) = *(const f32x4*)(state_pool + ((size_t)s * 15 + j + 1) * PW + c4 * 4);
        }
    }
    SEAM(0);
    if (IN(1)) {
        pg8::Gemm g{XB, WIN, M, NIN, DM}; pg8::StaticOrder S; S.init(M, NIN, G, bx);
        Epi1 E{Z, RSTD0, LB, out};
        pg8::gemm_phase<Epi1, pg8::StaticOrder, true, true>(lds, g, S, E);
    }
    SEAM(1);
    if (IN(2)) {
        for (int it = gt; it < M * 64; it += NGT) {
            const int row = it >> 6, c8 = it & 63, w = 2 << (c8 >> 4);
            const bf16* U = Z + (size_t)row * NIN + ZU + c8 * 8;
            const v4u cur = *(const v4u*)U;
            const float u0 = bflo(cur.x), u1 = bfhi(cur.x), u2 = bflo(cur.y), u3 = bfhi(cur.y), u4 = bflo(cur.z), u5 = bfhi(cur.z), u6 = bflo(cur.w), u7 = bfhi(cur.w);
            float s0 = u0, s1 = u1, s2 = u2, s3 = u3, s4 = u4, s5 = u5, s6 = u6, s7 = u7, inv;
            if (row < MP) { const int b = row / LP, t = row - b * LP, n = t < w - 1 ? t : w - 1;
                for (int jj = 1; jj <= n; ++jj) { const v4u p = *(const v4u*)(U - (size_t)jj * NIN);
                    s0 += bflo(p.x); s1 += bfhi(p.x); s2 += bflo(p.y); s3 += bfhi(p.y); s4 += bflo(p.z); s5 += bfhi(p.z); s6 += bflo(p.w); s7 += bfhi(p.w); }
                inv = 1.0f / (float)(n + 1);
            } else { const int sidx = row - MP;
                for (int jj = 1; jj < w; ++jj) { const float* sp = state_pool + ((size_t)sidx * 15 + (15 - jj)) * PW + c8 * 8; const f32x4 a = *(const f32x4*)sp, bq = *(const f32x4*)(sp + 4);
                    s0 += a[0]; s1 += a[1]; s2 += a[2]; s3 += a[3]; s4 += bq[0]; s5 += bq[1]; s6 += bq[2]; s7 += bq[3]; }
                inv = 1.0f / (float)w;
            }
            v4u o; o.x = pk2(s0 * inv - u0, s1 * inv - u1); o.y = pk2(s2 * inv - u2, s3 * inv - u3); o.z = pk2(s4 * inv - u4, s5 * inv - u5); o.w = pk2(s6 * inv - u6, s7 * inv - u7);
            *(v4u*)(PO + (size_t)row * PW + c8 * 8) = o;
        }
        for (int un = bx; un < NUNIT; un += G) { const int bh = un / NCH, c = un - bh * NCH;
            float* dS = c == 0 ? DS0 + (size_t)bh * 16384 : out + ((size_t)bh * 32 + (c - 1)) * 16384;
            scan_pass1_unit(lds, Z, dS, DVEC + (size_t)un * 128, bh >> 2, bh & 3, c, tid); }
    }
    SEAM(2);
    if (IN(3)) {
        for (int e = gt; e < NBH * 4096; e += NGT) { const int bh = e >> 12, rem = e & 4095, v = rem >> 5, k4 = rem & 31;
            f32x4 S = (f32x4){0.f, 0.f, 0.f, 0.f}; const size_t eo = (size_t)v * 128 + k4 * 4;
#pragma unroll 4
            for (int c = 0; c < NCH; ++c) {
                const float* dsp = (c == 0 ? DS0 + (size_t)bh * 16384 : out + ((size_t)bh * 32 + (c - 1)) * 16384) + eo;
                const f32x4 d = *(const f32x4*)(DVEC + (size_t)(bh * NCH + c) * 128 + k4 * 4), ds = *(const f32x4*)dsp;
                v2u o; o.x = pk2(S[0], S[1]); o.y = pk2(S[2], S[3]); *(v2u*)(ST + (size_t)(bh * NCH + c) * 16384 + eo) = o;
                S = d * S + ds; }
            float* fo = out + OUT_NHP + (size_t)bh * 16384 + (size_t)(k4 * 4) * 128 + v;
            fo[0] = S[0]; fo[128] = S[1]; fo[256] = S[2]; fo[384] = S[3];
        }
        for (int un = bx; un < NSAMP * 4; un += G)
            sample_hgrn_unit(lds, Z, state_hgrn, out + OUT_NHS, g_onorm, ON, un >> 2, un & 3, tid);
    }
    SEAM(3);
    if (IN(4)) {
        for (int un = bx; un < NUNIT; un += G) { const int bh = un / NCH, c = un - bh * NCH;
            scan_pass3_unit(lds, Z, ST + (size_t)un * 16384, g_onorm, ON, bh >> 2, bh & 3, c, tid); }
    }
    SEAM(4);
    if (IN(5)) {
        pg8::Gemm g{PO, WAB, 2 * M, 2 * DM, PW}; PairOrder S{G, bx};
        Epi2 E{Z, MB};
        pg8::gemm_phase<Epi2, PairOrder, true, true>(lds, g, S, E);
    }
    SEAM(5);
    if (IN(6)) {
        pg8::Gemm g{MB, WOUT, M, DM, DM}; pg8::StaticOrder S; S.init(M, DM, G, bx);
        Epi3 E{x_prompt, x_sample, meta, out, XMETA, X1B, SS1};
        pg8::gemm_phase<Epi3, pg8::StaticOrder, true, true>(lds, g, S, E);
    }
    SEAM(6);
    if (IN(7)) {
        pg8::Gemm g{X1B, WUP, M, FF, DM}; pg8::StaticOrder S; S.init(M, FF, G, bx);
        Epi4 E{AB, SS1};
        pg8::gemm_phase<Epi4, pg8::StaticOrder, true, true>(lds, g, S, E);
    }
    SEAM(7);
    if (IN(8)) {
        pg8::Gemm g{AB, WDOWN, M, DM, FF}; pg8::StaticOrder S; S.init(M, DM, G, bx);
        Epi5 E{out, XMETA, SS2};
        pg8::gemm_phase<Epi5, pg8::StaticOrder, true, true>(lds, g, S, E);
    }
    SEAM(8);
    if (IN(9)) {
        for (int m = gw; m < M; m += NGW) {
            if (m < MP && (m % LP) < NMETA) continue;
            const float rs = rstd_from_parts(SS2, m);
            f32x4* xr = (f32x4*)xsp_row(out, XMETA, m) + lane; const f32x4* gf = (const f32x4*)g_final + lane;
#pragma unroll
            for (int j = 0; j < 4; ++j) xr[64 * j] = xr[64 * j] * rs * gf[64 * j];
        }
    }
#undef IN
#undef SEAM
}

extern "C" void kernel_launch(void* const* d_in, const int* in_sizes, int n_in, void* d_out, int out_size, void* d_ws, size_t ws_size, hipStream_t stream) {
    static int grid = 0;
    if (grid == 0) {
        if (n_in != 18 || (size_t)out_size != OUT_END || ws_size < WS_END) { fprintf(stderr, "kernel_launch: unexpected shapes (n_in %d out %d ws %zu)\n", n_in, out_size, ws_size); grid = -1; return; }
        int dev = 0, cus = 0, per_cu = 0;
        hipGetDevice(&dev); hipDeviceGetAttribute(&cus, hipDeviceAttributeMultiprocessorCount, dev);
        if (hipFuncSetAttribute((const void*)hybrid_fwd, hipFuncAttributeMaxDynamicSharedMemorySize, LDS_BYTES) != hipSuccess) { fprintf(stderr, "kernel_launch: hipFuncSetAttribute failed\n"); grid = -1; return; }
        if (hipOccupancyMaxActiveBlocksPerMultiprocessor(&per_cu, (const void*)hybrid_fwd, NTHR, LDS_BYTES) != hipSuccess || per_cu < 1) { fprintf(stderr, "kernel_launch: occupancy query says %d\n", per_cu); per_cu = 1; }
        (void)hipGetLastError();
        grid = cus * 1;
        if (grid <= 0) grid = 256;
    }
    if (grid < 0) return;
    Args a{};
    for (int i = 0; i < 18; ++i) a.in[i] = (const float*)d_in[i];
    a.out = (float*)d_out; a.ws = (unsigned char*)d_ws;
#if MK_N_LAUNCHES == 1
    a.ph_lo = 0; a.ph_hi = NPHASE;
    void* kargs[] = {&a};
    hipError_t e = hipLaunchCooperativeKernel((const void*)hybrid_fwd, dim3(grid), dim3(NTHR), kargs, LDS_BYTES, stream);
    if (e != hipSuccess) fprintf(stderr, "kernel_launch: cooperative launch failed: %s (grid %d)\n", hipGetErrorString(e), grid);
#else
    for (int p = 0; p < NPHASE; ++p) { a.ph_lo = p; a.ph_hi = p + 1; hipLaunchKernelGGL(hybrid_fwd, dim3(grid), dim3(NTHR), LDS_BYTES, stream, a); }
#endif
}
```

```cpp
#include <hip/hip_runtime.h>
#include <hip/hip_cooperative_groups.h>
#include <cstdio>
#include <cstdint>
namespace cg = cooperative_groups;
namespace pg8 {
#define PG8_LAS __attribute__((address_space(3)))
typedef unsigned short bf16_t;
typedef short bf16x8 __attribute__((ext_vector_type(8)));
typedef float f32x4 __attribute__((ext_vector_type(4)));
typedef unsigned u32x4 __attribute__((ext_vector_type(4)));
constexpr int BM = 256, BK = 64, HALF = 128, HTB = HALF * BK * 2  , STAGE_BYTES = 8 * HTB, NXCD = 8, WGM = 8;

__host__ __device__ __forceinline__ int lds_byte(int r, int c) { const int st = (r >> 4) * 2 + (c >> 5), rr = r & 15, cc = c & 31, ob = rr * 64 + cc * 2; return st * 1024 + (ob ^ (((ob >> 9) & 1) << 5)); }
__host__ __device__ __forceinline__ void stage_rc(int b, int& R, int& C) { const int st = b / 1024, sb = b % 1024, swz = sb ^ (((sb >> 9) & 1) << 5); R = (st >> 1) * 16 + swz / 64; C = (st & 1) * 32 + (swz % 64) / 2; }
__host__ __device__ __forceinline__ int perm32(int rho) { const int n = rho >> 4, i = rho & 15; return 8 * (i >> 2) + 4 * n + (i & 3); }

struct Unit { int pm, pn; };
struct Gemm { const bf16_t* A; const bf16_t* Bt; int M, N, K; };

struct StaticOrder {
    int nM, nN, nwg, G, c;
    __host__ __device__ void init(int M, int N, int G_, int c_) { nM = M / BM; nN = N / BM; nwg = nM * nN; G = G_; c = c_; }
    __host__ __device__ bool next(int i, Unit& u) const {
        const long L = (long)i * G + c; if (L >= nwg) return false;
        int wgid = (int)L; { const int q = nwg / NXCD, r = nwg % NXCD, xcd = wgid % NXCD, off = wgid / NXCD; wgid = (xcd < r ? xcd * (q + 1) : r * (q + 1) + (xcd - r) * q) + off; }
        const int nig = WGM * nN, gid = wgid / nig, fm = gid * WGM, gsz = (nM - fm) < WGM ? (nM - fm) : WGM;
        u.pm = fm + ((wgid % nig) % gsz); u.pn = (wgid % nig) / gsz; return true;
    }
    __device__ __forceinline__ void a_ready(const Unit&) const {}
    __device__ __forceinline__ void done(const Unit&) const {}
};

__device__ __forceinline__ unsigned cvt_pk_bf16(float lo, float hi) { unsigned r; asm volatile("v_cvt_pk_bf16_f32 %0, %1, %2" : "=v"(r) : "v"(lo), "v"(hi)); return r; }
typedef float f32x2 __attribute__((ext_vector_type(2)));
template <class Epi, class Sched, bool ALIGN_EPI = false, bool SP2 = false>
__device__ __forceinline__ void gemm_phase(PG8_LAS unsigned char* lds, const Gemm g, const Sched& S, const Epi& E) {
    const int tid = threadIdx.x, wid = __builtin_amdgcn_readfirstlane(tid >> 6), lane = tid & 63, wr = wid >> 2, wc = wid & 3, fr = lane & 15, fq = lane >> 4;
    const int K = g.K, nt = K / BK;
    unsigned voffA[2], voffB[2];
#pragma unroll
    for (int i = 0; i < 2; ++i) { int R, C; stage_rc(tid * 16 + i * 8192, R, C); const int Rb = Epi::PERM ? ((R & ~31) + perm32(R & 31)) : R;
        voffA[i] = (unsigned)(R * K + C) * 2u; voffB[i] = (unsigned)(Rb * K + C) * 2u; }
    const size_t kstep = (size_t)(BK * 2);
    const size_t hstep = (size_t)HALF * K * 2;
    const size_t tstep = 2 * hstep;
    const unsigned ldsw = (unsigned)wid * 1024u;
    const int aoff = lds_byte(wr * 64 + fr, fq * 8), boff = lds_byte(wc * 32 + fr, fq * 8);
#define PG8_SA(b, h) (((b) * 2 + (h)) * HTB)
#define PG8_SB(b, h) ((4 + (b) * 2 + (h)) * HTB)
#define PG8_STAGE(bufoff, gbase, voff) do { _Pragma("unroll") for (int _i = 0; _i < 2; ++_i) \
        __builtin_amdgcn_global_load_lds((const unsigned*)((const char*)(gbase) + (voff)[_i]), (PG8_LAS unsigned*)(lds + (bufoff) + ldsw + _i * 8192), 16, 0, 0); } while (0)
#define PG8_LDA(dst, b, h) do { _Pragma("unroll") for (int m = 0; m < 4; ++m) _Pragma("unroll") for (int k = 0; k < 2; ++k) dst[m][k] = *(const PG8_LAS bf16x8*)(lds + PG8_SA(b, h) + aoff + m * 2048 + k * 1024); } while (0)
#define PG8_LDB(dst, b, h) do { _Pragma("unroll") for (int n = 0; n < 2; ++n) _Pragma("unroll") for (int k = 0; k < 2; ++k) dst[n][k] = *(const PG8_LAS bf16x8*)(lds + PG8_SB(b, h) + boff + n * 2048 + k * 1024); } while (0)
#define PG8_MMA(ai, bj, At, Bt) do { __builtin_amdgcn_s_setprio(1); _Pragma("unroll") for (int m = 0; m < 4; ++m) _Pragma("unroll") for (int n = 0; n < 2; ++n) _Pragma("unroll") for (int k = 0; k < 2; ++k) \
        acc[ai][bj][m][n] = __builtin_amdgcn_mfma_f32_16x16x32_bf16(Bt[n][k], At[m][k], acc[ai][bj][m][n], 0, 0, 0); __builtin_amdgcn_s_setprio(0); } while (0)
#define PG8_WAIT_V(n) asm volatile("s_waitcnt vmcnt(" #n ")" ::: "memory")
#define PG8_WAIT_L(n) asm volatile("s_waitcnt lgkmcnt(" #n ")" ::: "memory")
#define PG8_BAR __builtin_amdgcn_s_barrier()
#define PG8_SCHED __builtin_amdgcn_sched_barrier(0)
    Unit cur, nxt; int ui = 0;
    if (!S.next(0, cur)) return;
    f32x4 acc[2][2][4][2];
#pragma unroll
    for (int a = 0; a < 2; ++a)
#pragma unroll
        for (int b = 0; b < 2; ++b)
#pragma unroll
            for (int m = 0; m < 4; ++m)
#pragma unroll
                for (int n = 0; n < 2; ++n) acc[a][b][m][n] = (f32x4){0.f, 0.f, 0.f, 0.f};
    bf16x8 At[4][2], B0[2][2], B1[2][2];
    const char* cA = (const char*)g.A + (size_t)cur.pm * tstep; const char* cB = (const char*)g.Bt + (size_t)cur.pn * tstep;
    S.a_ready(cur);
    if constexpr (SP2) {
        PG8_STAGE(PG8_SB(0, 0), cB, voffB); PG8_STAGE(PG8_SB(0, 1), cB + hstep, voffB); PG8_STAGE(PG8_SA(0, 0), cA, voffA); PG8_STAGE(PG8_SA(0, 1), cA + hstep, voffA);
        if (wr == 1) PG8_BAR;
        PG8_WAIT_V(2); PG8_BAR;
        PG8_STAGE(PG8_SB(1, 0), cB + kstep, voffB); PG8_STAGE(PG8_SA(1, 0), cA + kstep, voffA); PG8_STAGE(PG8_SB(1, 1), cB + hstep + kstep, voffB);
        PG8_WAIT_V(6); PG8_BAR;
    } else {
        PG8_STAGE(PG8_SB(0, 0), cB, voffB); PG8_STAGE(PG8_SA(0, 0), cA, voffA); PG8_STAGE(PG8_SB(0, 1), cB + hstep, voffB); PG8_STAGE(PG8_SA(0, 1), cA + hstep, voffA);
        if (wr == 1) PG8_BAR;
        PG8_WAIT_V(4); PG8_BAR;
        PG8_STAGE(PG8_SB(1, 0), cB + kstep, voffB); PG8_STAGE(PG8_SA(1, 0), cA + kstep, voffA); PG8_STAGE(PG8_SB(1, 1), cB + hstep + kstep, voffB);
        PG8_WAIT_V(6); PG8_BAR;
    }
    for (;;) {
        const bool has_next = S.next(ui + 1, nxt);
        const char* nA = has_next ? (const char*)g.A + (size_t)nxt.pm * tstep : cA; const char* nB = has_next ? (const char*)g.Bt + (size_t)nxt.pn * tstep : cB;
        for (int t = 0; t < nt; t += 2) {
            const bool last = (t == nt - 2);
            const char* a1 = cA + (size_t)(t + 1) * kstep;
            const char* a2 = last ? nA : cA + (size_t)(t + 2) * kstep; const char* b2 = last ? nB : cB + (size_t)(t + 2) * kstep;
            const char* a3 = a2 + kstep; const char* b3 = b2 + kstep;
            if (last && has_next) S.a_ready(nxt);
            if constexpr (SP2) {
            PG8_LDB(B0, 0, 0); PG8_LDB(B1, 0, 1); PG8_SCHED; PG8_LDA(At, 0, 0); PG8_STAGE(PG8_SA(1, 1), a1 + hstep, voffA);
            PG8_WAIT_V(8); PG8_WAIT_L(0); PG8_BAR; PG8_MMA(0, 0, At, B0); PG8_MMA(0, 1, At, B1); PG8_BAR; PG8_SCHED;
            PG8_LDA(At, 0, 1); PG8_STAGE(PG8_SB(0, 0), b2, voffB); PG8_STAGE(PG8_SB(0, 1), b2 + hstep, voffB); PG8_STAGE(PG8_SA(0, 0), a2, voffA);
            PG8_WAIT_V(8); PG8_WAIT_L(0); PG8_BAR; PG8_MMA(1, 0, At, B0); PG8_MMA(1, 1, At, B1); PG8_BAR; PG8_SCHED;
            PG8_LDB(B0, 1, 0); PG8_LDB(B1, 1, 1); PG8_SCHED; PG8_LDA(At, 1, 0); PG8_STAGE(PG8_SA(0, 1), a2 + hstep, voffA);
            PG8_WAIT_V(8); PG8_WAIT_L(0); PG8_BAR; PG8_MMA(0, 0, At, B0); PG8_MMA(0, 1, At, B1); PG8_BAR; PG8_SCHED;
            PG8_LDA(At, 1, 1); PG8_STAGE(PG8_SB(1, 0), b3, voffB); PG8_STAGE(PG8_SB(1, 1), b3 + hstep, voffB); PG8_STAGE(PG8_SA(1, 0), a3, voffA);
            PG8_WAIT_V(8); PG8_WAIT_L(0); PG8_BAR; PG8_MMA(1, 0, At, B0); PG8_MMA(1, 1, At, B1); PG8_BAR; PG8_SCHED;
            } else {
            PG8_LDB(B0, 0, 0); PG8_SCHED; PG8_LDA(At, 0, 0); PG8_STAGE(PG8_SA(1, 1), a1 + hstep, voffA);
            PG8_WAIT_L(8); PG8_BAR; PG8_WAIT_L(0); PG8_MMA(0, 0, At, B0); PG8_BAR; PG8_SCHED;
            PG8_LDB(B1, 0, 1); PG8_STAGE(PG8_SB(0, 0), b2, voffB);
            PG8_BAR; PG8_WAIT_L(0); PG8_MMA(0, 1, At, B1); PG8_BAR;
            PG8_LDA(At, 0, 1); PG8_STAGE(PG8_SA(0, 0), a2, voffA);
            PG8_BAR; PG8_WAIT_L(0); PG8_MMA(1, 0, At, B0); PG8_BAR; PG8_SCHED;
            PG8_STAGE(PG8_SB(0, 1), b2 + hstep, voffB);
            PG8_WAIT_V(6); PG8_BAR; PG8_MMA(1, 1, At, B1); PG8_BAR;
            PG8_LDB(B0, 1, 0); PG8_SCHED; PG8_LDA(At, 1, 0); PG8_STAGE(PG8_SA(0, 1), a2 + hstep, voffA);
            PG8_WAIT_L(8); PG8_BAR; PG8_WAIT_L(0); PG8_MMA(0, 0, At, B0); PG8_BAR; PG8_SCHED;
            PG8_LDB(B1, 1, 1); PG8_STAGE(PG8_SB(1, 0), b3, voffB);
            PG8_BAR; PG8_WAIT_L(0); PG8_MMA(0, 1, At, B1); PG8_BAR;
            PG8_LDA(At, 1, 1); PG8_STAGE(PG8_SA(1, 0), a3, voffA);
            PG8_BAR; PG8_WAIT_L(0); PG8_MMA(1, 0, At, B0); PG8_BAR; PG8_SCHED;
            PG8_STAGE(PG8_SB(1, 1), b3 + hstep, voffB);
            PG8_WAIT_V(6); PG8_BAR; PG8_MMA(1, 1, At, B1); PG8_BAR;
            }
        }
        if constexpr (ALIGN_EPI) { if (wr == 0) PG8_BAR; }
        if constexpr (!Epi::AFTER_DRAIN) { E(acc, cur, wr, wc, fr, fq); S.done(cur); }
        if (!has_next) break;
#pragma unroll
        for (int a = 0; a < 2; ++a)
#pragma unroll
            for (int b = 0; b < 2; ++b)
#pragma unroll
                for (int m = 0; m < 4; ++m)
#pragma unroll
                    for (int n = 0; n < 2; ++n) acc[a][b][m][n] = (f32x4){0.f, 0.f, 0.f, 0.f};
        cur = nxt; cA = nA; cB = nB; ++ui;
        if constexpr (ALIGN_EPI) { if (wr == 1) PG8_BAR; }
    }
    PG8_WAIT_V(0);
    if constexpr (!ALIGN_EPI) { if (wr == 0) PG8_BAR; }
    PG8_BAR;
    if constexpr (Epi::AFTER_DRAIN) { E.fused(acc, cur, wr, wc, fr, fq, lds, wid, lane); S.done(cur); }
#undef PG8_SA
#undef PG8_SB
#undef PG8_STAGE
#undef PG8_LDA
#undef PG8_LDB
#undef PG8_MMA
#undef PG8_WAIT_V
#undef PG8_WAIT_L
#undef PG8_BAR
#undef PG8_SCHED
}
}

#define GAS __attribute__((address_space(1)))
#define LAS __attribute__((address_space(3)))
typedef unsigned short bf16;
typedef unsigned v4u __attribute__((ext_vector_type(4)));
typedef unsigned v2u __attribute__((ext_vector_type(2)));
typedef float f32x4 __attribute__((ext_vector_type(4)));
typedef short bf16x8 __attribute__((ext_vector_type(8)));
using pg8::Unit;

#ifndef MK_N_LAUNCHES
#define MK_N_LAUNCHES 1
#endif
constexpr int NPHASE = 10;
constexpr int NWAVES = 8, NTHR = 512;
constexpr int DM = 1024, NB = 8, SEQ = 2048, NMETA = 16, LP = SEQ + NMETA, NSAMP = 128;
constexpr int MP = NB * LP, M = MP + NSAMP, NMT = M / 256;
constexpr int MR = NB * SEQ, MC = MR + NSAMP, NRT = MR / 256;
constexpr int NIN = 4608, FF = 4096, PW = 512;
constexpr int NCH = 33, PADT = 48, NBH = 32, NUNIT = NBH * NCH;
constexpr float EPS = 1e-6f;
constexpr int ZU = 0, ZQ = 512, ZF = 1024, ZV = 1536, ZOG = 2048, ZGA = 2560, ZGB = 3584;
constexpr size_t OUT_YP = 0, OUT_YS = (size_t)NB * SEQ * DM, OUT_NPP = OUT_YS + (size_t)NSAMP * DM, OUT_NHP = OUT_NPP + (size_t)NB * 15 * PW,
                 OUT_NPS = OUT_NHP + (size_t)NB * 4 * 16384, OUT_NHS = OUT_NPS + (size_t)NSAMP * 15 * PW, OUT_END = OUT_NHS + (size_t)NSAMP * 4 * 16384;
constexpr size_t MiB = 1u << 20;
constexpr size_t WS_LB = 0, WS_RSTD0 = 64 * 1024, WS_SS1 = 256 * 1024, WS_SS2 = 1536 * 1024, WS_DVEC = 3 * MiB, WS_DS0 = 5 * MiB, WS_BAR = 7 * MiB;
constexpr size_t WS_WIN = 8 * MiB, WS_WAB = 17 * MiB, WS_WOUT = 19 * MiB, WS_WUP = 21 * MiB, WS_WDOWN = 29 * MiB;
constexpr size_t WS_RA = 37 * MiB;
constexpr size_t WS_RS = 70 * MiB;
constexpr size_t WS_Z = 103 * MiB;
constexpr size_t WS_END = 250 * MiB;
static_assert(WS_RA + (size_t)M * DM * 2 <= WS_RS && WS_RS + (size_t)NUNIT * 32768 <= WS_Z && WS_Z + (size_t)M * NIN * 2 <= WS_END, "ws map");
static_assert(WS_SS1 + 16 * (size_t)M * 4 <= WS_SS2 && WS_SS2 + 16 * (size_t)M * 4 <= WS_DVEC && WS_DVEC + (size_t)NUNIT * 512 <= WS_DS0, "ws small map");
constexpr int LDS_BYTES = 147456;

#define LDS_WAIT() asm volatile("s_waitcnt lgkmcnt(0)" ::: "memory")
__device__ __forceinline__ unsigned f2bf(float f) { unsigned u = __builtin_bit_cast(unsigned, f); return (u + 0x7fffu + ((u >> 16) & 1u)) >> 16; }
__device__ __forceinline__ unsigned pk2(float lo, float hi) { return pg8::cvt_pk_bf16(lo, hi); }
__device__ __forceinline__ float bflo(unsigned u) { return __builtin_bit_cast(float, u << 16); }
__device__ __forceinline__ float bfhi(unsigned u) { return __builtin_bit_cast(float, u & 0xffff0000u); }
__device__ __forceinline__ float bf1(unsigned short u) { return __builtin_bit_cast(float, (unsigned)u << 16); }
__device__ __forceinline__ float h1(unsigned short u) { return (float)__builtin_bit_cast(_Float16, u); }
__device__ __forceinline__ unsigned pkh2(float lo, float hi) { const _Float16 a = (_Float16)lo, b = (_Float16)hi; return (unsigned)__builtin_bit_cast(unsigned short, a) | ((unsigned)__builtin_bit_cast(unsigned short, b) << 16); }
__device__ __forceinline__ float frcp(float x) { return __builtin_amdgcn_rcpf(x); }
__device__ __forceinline__ float sigm(float x) { return frcp(1.0f + __expf(-x)); }
__device__ __forceinline__ float wave_sum(float v) {
#pragma unroll
    for (int o = 1; o < 64; o <<= 1) v += __shfl_xor(v, o);
    return v;
}
__device__ __forceinline__ const float* xin_full(const float* xp, const float* xs, const float* meta, int r) {
    if (r >= MP) return xs + (size_t)(r - MP) * DM;
    const int b = r / LP, t = r - b * LP;
    return t < NMETA ? meta + (size_t)t * DM : xp + ((size_t)b * SEQ + (t - NMETA)) * DM;
}
__device__ __forceinline__ int full_of_compact(int cr) { return cr < MR ? (cr >> 11) * LP + NMETA + (cr & (SEQ - 1)) : cr + (MP - MR); }

struct Epi1 {
    static constexpr bool PERM = true, AFTER_DRAIN = false;
    bf16* Z; const float* rstd0; const float* lb; float* out;
    __device__ __forceinline__ void operator()(const f32x4 (&acc)[2][2][4][2], const Unit& u, int wr, int wc, int fr, int fq) const {
        const int row0 = u.pm * 256 + wr * 64 + fr, colb = u.pn * 256 + wc * 32 + 8 * fq;
        const int type = u.pn < 10 ? (u.pn >> 1) : (u.pn < 14 ? 5 : 6);
#pragma unroll
        for (int ai = 0; ai < 2; ++ai)
#pragma unroll
            for (int m = 0; m < 4; ++m) {
                const int row = row0 + ai * 128 + m * 16; const float rs = rstd0[row];
                bf16* zr = Z + (size_t)row * NIN;
                float* pdst = nullptr;
                if (type == 0) { if (row >= MP) pdst = out + OUT_NPS + ((size_t)(row - MP) * 15 + 14) * PW; else { const int b = row / LP, t = row - b * LP; if (t >= LP - 15) pdst = out + OUT_NPP + ((size_t)b * 15 + (t - (LP - 15))) * PW; } }
#pragma unroll
                for (int bj = 0; bj < 2; ++bj) {
                    const int col = colb + bj * 128;
                    f32x4 v0 = acc[ai][bj][m][0] * rs, v1 = acc[ai][bj][m][1] * rs; v4u w;
                    if (type == 0 || type == 3) {
                        if (pdst) { *(f32x4*)(pdst + col) = v0; *(f32x4*)(pdst + col + 4) = v1; }
                        w.x = pk2(v0[0], v0[1]); w.y = pk2(v0[2], v0[3]); w.z = pk2(v1[0], v1[1]); w.w = pk2(v1[2], v1[3]);
                    } else if (type == 2) {
                        const f32x4 l0 = *(const f32x4*)(lb + col - ZF), l1 = *(const f32x4*)(lb + col - ZF + 4);
#pragma unroll
                        for (int e = 0; e < 4; ++e) { v0[e] = __logf(l0[e] + (1.0f - l0[e]) * sigm(v0[e])); v1[e] = __logf(l1[e] + (1.0f - l1[e]) * sigm(v1[e])); }
                        w.x = pkh2(v0[0], v0[1]); w.y = pkh2(v0[2], v0[3]); w.z = pkh2(v1[0], v1[1]); w.w = pkh2(v1[2], v1[3]);
                    } else {
#pragma unroll
                        for (int e = 0; e < 4; ++e) { const float s0 = sigm(v0[e]), s1 = sigm(v1[e]); v0[e] = type >= 5 ? s0 : v0[e] * s0; v1[e] = type >= 5 ? s1 : v1[e] * s1; }
                        w.x = pk2(v0[0], v0[1]); w.y = pk2(v0[2], v0[3]); w.z = pk2(v1[0], v1[1]); w.w = pk2(v1[2], v1[3]);
                    }
                    *(v4u*)(zr + col) = w;
                }
            }
    }
};
struct PairOrder {
    int G, c;
    __device__ bool next(int i, Unit& u) const { const int L = (i >> 1) * G + c; if (L >= NRT * 4) return false; const int half = i & 1; u.pm = (L >> 2) + half * NMT; u.pn = (L & 3) + half * 4; return true; }
    __device__ __forceinline__ void a_ready(const Unit&) const {}
    __device__ __forceinline__ void done(const Unit&) const {}
};
struct Epi2 {
    static constexpr bool PERM = false, AFTER_DRAIN = false;
    const bf16* Z; bf16* MB;
    __device__ __forceinline__ void operator()(const f32x4 (&acc)[2][2][4][2], const Unit& u, int wr, int wc, int fr, int fq) const {
        const int half = u.pm >= NMT ? 1 : 0;
        const int row0 = (u.pm - half * NMT) * 256 + wr * 64 + fr, colb = (u.pn - half * 4) * 256 + wc * 32 + 4 * fq;
        const int zoff = half ? ZGB : ZGA;
#pragma unroll
        for (int ai = 0; ai < 2; ++ai)
#pragma unroll
            for (int m = 0; m < 4; ++m) {
                const int row = row0 + ai * 128 + m * 16; const bf16* zr = Z + (size_t)full_of_compact(row) * NIN + zoff; bf16* mr = MB + (size_t)row * DM;
#pragma unroll
                for (int bj = 0; bj < 2; ++bj)
#pragma unroll
                    for (int n = 0; n < 2; ++n) {
                        const int col = colb + bj * 128 + n * 16;
                        const v2u g = *(const v2u*)(zr + col); const f32x4 a = acc[ai][bj][m][n];
                        float r0 = bflo(g.x) * a[0], r1 = bfhi(g.x) * a[1], r2 = bflo(g.y) * a[2], r3 = bfhi(g.y) * a[3];
                        if (half) { const v2u t = *(const v2u*)(mr + col); r0 += bflo(t.x); r1 += bfhi(t.x); r2 += bflo(t.y); r3 += bfhi(t.y); }
                        v2u o; o.x = pk2(r0, r1); o.y = pk2(r2, r3); *(v2u*)(mr + col) = o;
                    }
            }
    }
};
struct Epi3 {
    static constexpr bool PERM = false, AFTER_DRAIN = false;
    const float* xp; float* out; bf16* X1B; float* SS;
    __device__ __forceinline__ void operator()(const f32x4 (&acc)[2][2][4][2], const Unit& u, int wr, int wc, int fr, int fq) const {
        const int row0 = u.pm * 256 + wr * 64 + fr, colb = u.pn * 256 + wc * 32 + 4 * fq;
#pragma unroll
        for (int ai = 0; ai < 2; ++ai)
#pragma unroll
            for (int m = 0; m < 4; ++m) {
                const int row = row0 + ai * 128 + m * 16; const float* xi = xp + (size_t)row * DM; float* xo = out + (size_t)row * DM; bf16* xb = X1B + (size_t)row * DM;
                float s = 0.f;
#pragma unroll
                for (int bj = 0; bj < 2; ++bj)
#pragma unroll
                    for (int n = 0; n < 2; ++n) {
                        const int col = colb + bj * 128 + n * 16;
                        const f32x4 v = *(const f32x4*)(xi + col) + acc[ai][bj][m][n];
                        *(f32x4*)(xo + col) = v; s += (v[0] * v[0] + v[1] * v[1]) + (v[2] * v[2] + v[3] * v[3]);
                        v2u o; o.x = pk2(v[0], v[1]); o.y = pk2(v[2], v[3]); *(v2u*)(xb + col) = o;
                    }
                s += __shfl_xor(s, 16); s += __shfl_xor(s, 32);
                if (fq == 0) SS[(size_t)(u.pn * 4 + wc) * M + row] = s;
            }
    }
};
__device__ __forceinline__ float rstd_from_parts(const float* SS, int row) {
    float s = 0.f;
#pragma unroll
    for (int p = 0; p < 16; ++p) s += SS[(size_t)p * M + row];
    return __builtin_amdgcn_rsqf(s * (1.0f / DM) + EPS);
}
struct Epi4 {
    static constexpr bool PERM = true, AFTER_DRAIN = false;
    bf16* AB; const float* SS;
    __device__ __forceinline__ void operator()(const f32x4 (&acc)[2][2][4][2], const Unit& u, int wr, int wc, int fr, int fq) const {
        const int row0 = u.pm * 256 + wr * 64 + fr, colb = u.pn * 256 + wc * 32 + 8 * fq;
#pragma unroll
        for (int ai = 0; ai < 2; ++ai)
#pragma unroll
            for (int m = 0; m < 4; ++m) {
                const int row = row0 + ai * 128 + m * 16; const float rs = rstd_from_parts(SS, row); bf16* ar = AB + (size_t)row * FF;
#pragma unroll
                for (int bj = 0; bj < 2; ++bj) {
                    f32x4 v0 = acc[ai][bj][m][0] * rs, v1 = acc[ai][bj][m][1] * rs;
#pragma unroll
                    for (int e = 0; e < 4; ++e) { const float a = fmaxf(v0[e], 0.f), b = fmaxf(v1[e], 0.f); v0[e] = a * a; v1[e] = b * b; }
                    v4u w; w.x = pk2(v0[0], v0[1]); w.y = pk2(v0[2], v0[3]); w.z = pk2(v1[0], v1[1]); w.w = pk2(v1[2], v1[3]);
                    *(v4u*)(ar + colb + bj * 128) = w;
                }
            }
    }
};
struct Epi5 {
    static constexpr bool PERM = false, AFTER_DRAIN = false;
    float* out; float* SS;
    __device__ __forceinline__ void operator()(const f32x4 (&acc)[2][2][4][2], const Unit& u, int wr, int wc, int fr, int fq) const {
        const int row0 = u.pm * 256 + wr * 64 + fr, colb = u.pn * 256 + wc * 32 + 4 * fq;
#pragma unroll
        for (int ai = 0; ai < 2; ++ai)
#pragma unroll
            for (int m = 0; m < 4; ++m) {
                const int row = row0 + ai * 128 + m * 16; float* xo = out + (size_t)row * DM;
                float s = 0.f;
#pragma unroll
                for (int bj = 0; bj < 2; ++bj)
#pragma unroll
                    for (int n = 0; n < 2; ++n) {
                        const int col = colb + bj * 128 + n * 16;
                        const f32x4 v = *(const f32x4*)(xo + col) + acc[ai][bj][m][n];
                        *(f32x4*)(xo + col) = v; s += (v[0] * v[0] + v[1] * v[1]) + (v[2] * v[2] + v[3] * v[3]);
                    }
                s += __shfl_xor(s, 16); s += __shfl_xor(s, 32);
                if (fq == 0) SS[(size_t)(u.pn * 4 + wc) * M + row] = s;
            }
    }
};
#define XB_TMO      128
#define XB_XCNT(j)  (256  + 64 * (j))
#define XB_XSUB(j)  (1280 + 64 * (j))
#define XB_XGEN(j)  (2304 + 64 * (j))
#define XB_TOP      3328
#define XB_TOPGEN   3392
#define XCD_BAR_WORDS 3456
#define XB_SPIN_CAP (1u << 18)

__device__ __forceinline__ unsigned xb_ld(unsigned* p)              { return __hip_atomic_load(p, __ATOMIC_RELAXED, __HIP_MEMORY_SCOPE_AGENT); }
__device__ __forceinline__ unsigned xb_add(unsigned* p, unsigned v) { return __hip_atomic_fetch_add(p, v, __ATOMIC_RELAXED, __HIP_MEMORY_SCOPE_AGENT); }
__device__ __forceinline__ unsigned xb_xcc_id() { return (unsigned)__builtin_amdgcn_s_getreg((3 << 11) | 20) & 0xFu; }
#define XB_SPIN(cond, bar) do { unsigned _sp = 0; while (cond) { __builtin_amdgcn_s_sleep(1); \
    if ((++_sp & 255u) == 0u) { if (xb_ld(&(bar)[XB_TMO])) break; if (_sp > XB_SPIN_CAP) { atomicAdd(&(bar)[XB_TMO], 1u); break; } } } } while (0)

struct XcdBarrier {
    unsigned* bar; unsigned x;
    volatile LAS unsigned* st;
};

__device__ __forceinline__ XcdBarrier xcd_barrier_post(unsigned* bar, volatile LAS unsigned* st) {
    XcdBarrier b; b.bar = bar; b.x = xb_xcc_id(); b.st = st;
    if (threadIdx.x == 0) (void)xb_add(&bar[XB_XCNT(b.x)], 1u);
    return b;
}
__device__ __forceinline__ void xcd_barrier_complete(unsigned* bar, unsigned x, unsigned& nloc, unsigned& nx) {
    const unsigned G = gridDim.x * gridDim.y * gridDim.z;
    unsigned sum, cnt, mine, sp = 0u;
    for (;;) {
        sum = 0u; cnt = 0u; mine = 0u;
#pragma unroll
        for (unsigned j = 0; j < 16; ++j) { const unsigned c = xb_ld(&bar[XB_XCNT(j)]); sum += c; cnt += (c > 0u) ? 1u : 0u; mine = (j == x) ? c : mine; }
        if (sum == G) break;
        __builtin_amdgcn_s_sleep(1);
        if ((++sp & 255u) == 0u) { if (xb_ld(&bar[XB_TMO])) break; if (sp > XB_SPIN_CAP) { atomicAdd(&bar[XB_TMO], 1u); break; } }
    }
    nloc = mine > 0u ? mine : 1u; nx = cnt > 0u ? cnt : 1u;
}

__device__ __forceinline__ void xcd_barrier(const XcdBarrier& b) {
    asm volatile("s_waitcnt vmcnt(0)" ::: "memory");
    __syncthreads();
    if (threadIdx.x == 0) {
        unsigned* bar = b.bar;
        __builtin_amdgcn_s_waitcnt(0);
        unsigned nloc = b.st[0], nx = b.st[1];
        if (nloc == 0u) { xcd_barrier_complete(bar, b.x, nloc, nx); b.st[0] = nloc; b.st[1] = nx; }
        const unsigned old = xb_add(&bar[XB_XSUB(b.x)], 1u);
        const unsigned gen = old / nloc;
        if (old + 1u == (gen + 1u) * nloc) {
            __builtin_amdgcn_fence(__ATOMIC_RELEASE, "agent");
            asm volatile("s_waitcnt vmcnt(0)" ::: "memory");
            const unsigned og = xb_add(&bar[XB_TOP], 1u);
            const unsigned tg = og / nx;
            if (og + 1u == (tg + 1u) * nx) xb_add(&bar[XB_TOPGEN], 1u);
            else XB_SPIN(xb_ld(&bar[XB_TOPGEN]) == tg, bar);
            __builtin_amdgcn_fence(__ATOMIC_ACQUIRE, "agent");
            xb_add(&bar[XB_XGEN(b.x)], 1u);
            asm volatile("s_waitcnt vmcnt(0)" ::: "memory");
        } else {
            XB_SPIN(xb_ld(&bar[XB_XGEN(b.x)]) == gen, bar);
            __builtin_amdgcn_fence(__ATOMIC_ACQUIRE, "agent");
            asm volatile("s_waitcnt vmcnt(0)" ::: "memory");
        }
    }
    __syncthreads();
}

__device__ __forceinline__ void p0_transpose_item(const float* W, const float* rsc, int K, int N, bf16* WT, int row_off, LAS float* scr, int item, int lane) {
    const int nblk = N / 32, kb = item / nblk, nb = item % nblk, k0 = 64 * kb, n0 = 32 * nb;
#pragma unroll 8
    for (int i = 0; i < 32; ++i) { const int kk = 2 * i + (lane >> 5); float w = W[(size_t)(k0 + kk) * N + n0 + (lane & 31)]; if (rsc) w *= rsc[k0 + kk]; scr[kk * 33 + (lane & 31)] = w; }
    LDS_WAIT(); asm volatile("" ::: "memory");
    const int c = lane & 7;
#pragma unroll
    for (int j = 0; j < 4; ++j) { const int n = (lane >> 3) + 8 * j; const LAS float* s = scr + (8 * c) * 33 + n;
        v4u o; o.x = pk2(s[0 * 33], s[1 * 33]); o.y = pk2(s[2 * 33], s[3 * 33]); o.z = pk2(s[4 * 33], s[5 * 33]); o.w = pk2(s[6 * 33], s[7 * 33]);
        *(v4u*)(WT + (size_t)(row_off + n0 + n) * K + k0 + 8 * c) = o; }
    LDS_WAIT(); asm volatile("" ::: "memory");
}
__device__ __forceinline__ void p0_fold_item(const float* w_pool, const float* ps, const float* w_a, bf16* WT, int item, int lane) {
    const int g = item >> 8, rem = item & 255, c0 = (rem >> 4) * 8, n0 = (rem & 15) * 64;
    float a0 = 0.f, a1 = 0.f, a2 = 0.f, a3 = 0.f, a4 = 0.f, a5 = 0.f, a6 = 0.f, a7 = 0.f;
    const float* wp = w_pool + ((size_t)g * 128 + c0) * 128;
    for (int d = 0; d < 128; ++d) {
        const float wa = w_a[(size_t)(g * 128 + d) * DM + n0 + lane] * ps[g * 128 + d];
        a0 += wp[d] * wa; a1 += wp[128 + d] * wa; a2 += wp[256 + d] * wa; a3 += wp[384 + d] * wa;
        a4 += wp[512 + d] * wa; a5 += wp[640 + d] * wa; a6 += wp[768 + d] * wa; a7 += wp[896 + d] * wa;
    }
    v4u o; o.x = pk2(a0, a1); o.y = pk2(a2, a3); o.z = pk2(a4, a5); o.w = pk2(a6, a7);
    *(v4u*)(WT + (size_t)(n0 + lane) * PW + g * 128 + c0) = o;
}

#define SCAN_LOAD_G(gv, valid, zbase) do { _Pragma("unroll") for (int jj = 0; jj < 16; ++jj) gv[jj] = (valid) ? h1((zbase)[(size_t)jj * NIN]) : 0.f; } while (0)

__device__ __forceinline__ void scan_pass1_unit(LAS unsigned char* lds, const bf16* Z, float* dS, float* dv, int b, int h, int c, int tid) {
    LAS unsigned char* VT = lds; LAS unsigned char* KT = lds + 18432; LAS float* GP = (LAS float*)(lds + 36864);
    const int k = tid & 127, part = tid >> 7, wid = tid >> 6, lane = tid & 63, r = lane & 15, q = lane >> 4;
    const int t0 = c * 64 - PADT;
    const bool valid = (c > 0) || (part == 3);
    const long rowbase = (long)b * LP + t0;
    float gv[16];
    { const bf16* zg = Z + (rowbase + part * 16) * NIN + ZF + h * 128 + k; SCAN_LOAD_G(gv, valid, zg); }
    float G[16]; G[0] = gv[0];
#pragma unroll
    for (int jj = 1; jj < 16; ++jj) G[jj] = G[jj - 1] + gv[jj];
    GP[part * 128 + k] = G[15];
#pragma unroll
    for (int i = 0; i < 2; ++i) { const int idx = tid + 512 * i, j = idx >> 4, v8 = idx & 15; v4u w = (v4u){0u, 0u, 0u, 0u};
        if (c > 0 || j >= PADT) w = *(const v4u*)(Z + (rowbase + j) * NIN + ZV + h * 128 + v8 * 8);
        LAS unsigned short* d = (LAS unsigned short*)VT + (v8 * 8) * 72 + j;
        d[0] = (unsigned short)w.x; d[72] = (unsigned short)(w.x >> 16); d[144] = (unsigned short)w.y; d[216] = (unsigned short)(w.y >> 16);
        d[288] = (unsigned short)w.z; d[360] = (unsigned short)(w.z >> 16); d[432] = (unsigned short)w.w; d[504] = (unsigned short)(w.w >> 16); }
    __syncthreads();
    float off = 0.f, tot = 0.f;
#pragma unroll
    for (int p = 0; p < 4; ++p) { const float x = GP[p * 128 + k]; tot += x; if (p < part) off += x; }
    { unsigned w[8];
#pragma unroll
      for (int jj = 0; jj < 16; jj += 2) {
          const float k0 = valid ? (1.0f - __expf(gv[jj])) * __expf(tot - (off + G[jj])) : 0.f;
          const float k1 = valid ? (1.0f - __expf(gv[jj + 1])) * __expf(tot - (off + G[jj + 1])) : 0.f;
          w[jj >> 1] = pk2(k0, k1); }
      LAS v4u* d = (LAS v4u*)(KT + (k * 72 + part * 16) * 2);
      d[0] = (v4u){w[0], w[1], w[2], w[3]}; d[1] = (v4u){w[4], w[5], w[6], w[7]}; }
    if (part == 0) dv[k] = __expf(tot);
    __syncthreads();
    bf16x8 a0 = *(const LAS bf16x8*)(VT + ((16 * wid + r) * 72 + 8 * q) * 2), a1 = *(const LAS bf16x8*)(VT + ((16 * wid + r) * 72 + 8 * q + 32) * 2);
#pragma unroll
    for (int nb = 0; nb < 8; ++nb) {
        const bf16x8 b0 = *(const LAS bf16x8*)(KT + ((16 * nb + r) * 72 + 8 * q) * 2), b1 = *(const LAS bf16x8*)(KT + ((16 * nb + r) * 72 + 8 * q + 32) * 2);
        f32x4 acc = (f32x4){0.f, 0.f, 0.f, 0.f};
        acc = __builtin_amdgcn_mfma_f32_16x16x32_bf16(a0, b0, acc, 0, 0, 0);
        acc = __builtin_amdgcn_mfma_f32_16x16x32_bf16(a1, b1, acc, 0, 0, 0);
#pragma unroll
        for (int i = 0; i < 4; ++i) dS[(16 * wid + 4 * q + i) * 128 + 16 * nb + r] = acc[i];
    }
    __syncthreads();
}

__device__ __forceinline__ void scan_pass3_unit(LAS unsigned char* lds, const bf16* Z, const bf16* St, const float* g_onorm, bf16* ON, int b, int h, int c, int tid) {
    LAS unsigned char* Q1 = lds; LAS unsigned char* KT = lds + 17408; LAS unsigned char* SP = lds + 34816; LAS unsigned char* VT = lds + 69632; LAS unsigned char* A1 = lds + 88064;
    LAS float* GP = (LAS float*)(lds + 97280); LAS float* GR = (LAS float*)(lds + 99328); LAS float* SSX = (LAS float*)(lds + 99840);
    const int k = tid & 127, part = tid >> 7, wid = tid >> 6, lane = tid & 63, r = lane & 15, q = lane >> 4;
    const int t0 = c * 64 - PADT;
    const bool valid = (c > 0) || (part == 3);
    const long rowbase = (long)b * LP + t0;
    float gv[16];
    { const bf16* zg = Z + (rowbase + part * 16) * NIN + ZF + h * 128 + k; SCAN_LOAD_G(gv, valid, zg); }
    float G[16]; G[0] = gv[0];
#pragma unroll
    for (int jj = 1; jj < 16; ++jj) G[jj] = G[jj - 1] + gv[jj];
    GP[part * 128 + k] = G[15];
#pragma unroll
    for (int i = 0; i < 2; ++i) { const int idx = tid + 512 * i, j = idx >> 4, v8 = idx & 15; v4u w = (v4u){0u, 0u, 0u, 0u};
        if (c > 0 || j >= PADT) w = *(const v4u*)(Z + (rowbase + j) * NIN + ZV + h * 128 + v8 * 8);
        LAS unsigned short* d = (LAS unsigned short*)VT + (v8 * 8) * 72 + j;
        d[0] = (unsigned short)w.x; d[72] = (unsigned short)(w.x >> 16); d[144] = (unsigned short)w.y; d[216] = (unsigned short)(w.y >> 16);
        d[288] = (unsigned short)w.z; d[360] = (unsigned short)(w.z >> 16); d[432] = (unsigned short)w.w; d[504] = (unsigned short)(w.w >> 16); }
    __syncthreads();
    float off = 0.f;
#pragma unroll
    for (int p = 0; p < 4; ++p) { const float x = GP[p * 128 + k]; if (p < part) off += x; }
    const float gref = GP[k] + GP[128 + k];
    if (part == 0) GR[k] = __expf(gref);
    { const bf16* zq = Z + (rowbase + part * 16) * NIN + ZQ + h * 128 + k;
#pragma unroll
      for (int jj = 0; jj < 16; ++jj) {
          const float Gj = off + G[jj];
          const float qv = valid ? bf1(zq[(size_t)jj * NIN]) * __expf(Gj - gref) : 0.f;
          const float kv = valid ? (1.0f - __expf(gv[jj])) * __expf(gref - Gj) : 0.f;
          const int j = part * 16 + jj;
          ((LAS unsigned short*)Q1)[j * 136 + k] = (unsigned short)f2bf(qv);
          ((LAS unsigned short*)KT)[j * 136 + k] = (unsigned short)f2bf(kv);
      } }
    __syncthreads();
#pragma unroll
    for (int i = 0; i < 4; ++i) { const int idx = tid + 512 * i, v = idx >> 4, k8 = idx & 15;
        const v4u w = *(const v4u*)(St + (size_t)v * 128 + k8 * 8); const LAS float* gr = GR + k8 * 8;
        v4u o; o.x = pk2(bflo(w.x) * gr[0], bfhi(w.x) * gr[1]); o.y = pk2(bflo(w.y) * gr[2], bfhi(w.y) * gr[3]); o.z = pk2(bflo(w.z) * gr[4], bfhi(w.z) * gr[5]); o.w = pk2(bflo(w.w) * gr[6], bfhi(w.w) * gr[7]);
        *(LAS v4u*)(SP + (v * 136 + k8 * 8) * 2) = o; }
    { const int tb = wid >> 1;
      bf16x8 a[4];
#pragma unroll
      for (int ks = 0; ks < 4; ++ks) a[ks] = *(const LAS bf16x8*)(Q1 + ((16 * tb + r) * 136 + 8 * q + 32 * ks) * 2);
#pragma unroll
      for (int s2 = 0; s2 < 2; ++s2) { const int sb = 2 * (wid & 1) + s2; f32x4 acc = (f32x4){0.f, 0.f, 0.f, 0.f};
          if (sb <= tb) {
#pragma unroll
              for (int ks = 0; ks < 4; ++ks) { const bf16x8 bb = *(const LAS bf16x8*)(KT + ((16 * sb + r) * 136 + 8 * q + 32 * ks) * 2); acc = __builtin_amdgcn_mfma_f32_16x16x32_bf16(a[ks], bb, acc, 0, 0, 0); }
          }
#pragma unroll
          for (int i = 0; i < 4; ++i) { const int t = 16 * tb + 4 * q + i, s = 16 * sb + r; ((LAS unsigned short*)A1)[t * 72 + s] = (unsigned short)f2bf(s <= t ? acc[i] : 0.f); }
      } }
    __syncthreads();
    const int tb = wid & 3, vb0 = 4 * (wid >> 2);
    f32x4 o[4];
    { bf16x8 a1[2], aq[4];
#pragma unroll
      for (int ks = 0; ks < 2; ++ks) a1[ks] = *(const LAS bf16x8*)(A1 + ((16 * tb + r) * 72 + 8 * q + 32 * ks) * 2);
#pragma unroll
      for (int ks = 0; ks < 4; ++ks) aq[ks] = *(const LAS bf16x8*)(Q1 + ((16 * tb + r) * 136 + 8 * q + 32 * ks) * 2);
#pragma unroll
      for (int vi = 0; vi < 4; ++vi) { const int vb = vb0 + vi; f32x4 acc = (f32x4){0.f, 0.f, 0.f, 0.f};
#pragma unroll
          for (int ks = 0; ks < 2; ++ks) { const bf16x8 bb = *(const LAS bf16x8*)(VT + ((16 * vb + r) * 72 + 8 * q + 32 * ks) * 2); acc = __builtin_amdgcn_mfma_f32_16x16x32_bf16(a1[ks], bb, acc, 0, 0, 0); }
#pragma unroll
          for (int ks = 0; ks < 4; ++ks) { const bf16x8 bb = *(const LAS bf16x8*)(SP + ((16 * vb + r) * 136 + 8 * q + 32 * ks) * 2); acc = __builtin_amdgcn_mfma_f32_16x16x32_bf16(aq[ks], bb, acc, 0, 0, 0); }
          o[vi] = acc; } }
    float ss[4];
#pragma unroll
    for (int i = 0; i < 4; ++i) { float s = (o[0][i] * o[0][i] + o[1][i] * o[1][i]) + (o[2][i] * o[2][i] + o[3][i] * o[3][i]);
        s += __shfl_xor(s, 1); s += __shfl_xor(s, 2); s += __shfl_xor(s, 4); s += __shfl_xor(s, 8); ss[i] = s; }
    if (r == 0) {
#pragma unroll
        for (int i = 0; i < 4; ++i) SSX[(16 * tb + 4 * q + i) * 2 + (wid >> 2)] = ss[i]; }
    __syncthreads();
#pragma unroll
    for (int i = 0; i < 4; ++i) { const int t = 16 * tb + 4 * q + i; const float rstd = __builtin_amdgcn_rsqf((SSX[t * 2] + SSX[t * 2 + 1]) * (1.0f / 128.0f) + EPS);
        { const size_t row = rowbase + t; const size_t crow = (size_t)b * SEQ + (size_t)(c - 1) * 64 + t;
#pragma unroll
            for (int vi = 0; vi < 4; ++vi) { const int vc = 16 * (vb0 + vi) + r; const float og = bf1(Z[row * NIN + ZOG + h * 128 + vc]);
                ON[crow * PW + h * 128 + vc] = (bf16)f2bf(o[vi][i] * rstd * g_onorm[vc] * og); } } }
    __syncthreads();
}

__device__ __forceinline__ void sample_hgrn_unit(LAS unsigned char* lds, const bf16* Z, const float* S0, float* Sout, const float* g_onorm, bf16* ON, int s, int h, int tid) {
    LAS float* OP = (LAS float*)lds;
    const size_t row = (size_t)MP + s; const bf16* zr = Z + row * NIN;
    const int v4 = tid & 31, kb = tid >> 5;
    const v2u vw = *(const v2u*)(zr + ZV + h * 128 + v4 * 4); const f32x4 vv = (f32x4){bflo(vw.x), bfhi(vw.x), bflo(vw.y), bfhi(vw.y)};
    f32x4 o4 = (f32x4){0.f, 0.f, 0.f, 0.f};
    const size_t sb = ((size_t)(s * 4 + h) * 128) * 128 + v4 * 4;
#pragma unroll
    for (int i = 0; i < 8; ++i) { const int k = kb + 16 * i; const float f = __expf(h1(zr[ZF + h * 128 + k])), kk = 1.0f - f, qk = bf1(zr[ZQ + h * 128 + k]);
        const f32x4 sn = *(const f32x4*)(S0 + sb + (size_t)k * 128) * f + vv * kk; *(f32x4*)(Sout + sb + (size_t)k * 128) = sn; o4 += sn * qk; }
    *(LAS f32x4*)(OP + kb * 128 + v4 * 4) = o4;
    __syncthreads();
    if (tid < 64) { float oa = 0.f, ob = 0.f;
#pragma unroll
        for (int p = 0; p < 16; ++p) { oa += OP[p * 128 + tid]; ob += OP[p * 128 + 64 + tid]; }
        const float rstd = __builtin_amdgcn_rsqf(wave_sum(oa * oa + ob * ob) * (1.0f / 128.0f) + EPS);
        ON[((size_t)MR + s) * PW + h * 128 + tid] = (bf16)f2bf(oa * rstd * g_onorm[tid] * bf1(zr[ZOG + h * 128 + tid]));
        ON[((size_t)MR + s) * PW + h * 128 + 64 + tid] = (bf16)f2bf(ob * rstd * g_onorm[64 + tid] * bf1(zr[ZOG + h * 128 + 64 + tid])); }
    __syncthreads();
}

__device__ __forceinline__ void skinny_mma(f32x4 (&acc)[4], const bf16* A, int lda, const bf16* Bt, int ldb, int K, int row0, int n0, int wave, int r, int q) {
    const int kw = K >> 3;
    const bf16* ap = A + (size_t)(row0 + r) * lda + wave * kw + 8 * q;
    const bf16* bp = Bt + (size_t)(n0 + r) * ldb + wave * kw + 8 * q;
#pragma unroll 2
    for (int ks = 0; ks < kw; ks += 32) {
        const bf16x8 a = *(const bf16x8*)(ap + ks);
#pragma unroll
        for (int nb = 0; nb < 4; ++nb) { const bf16x8 bb = *(const bf16x8*)(bp + (size_t)nb * 16 * ldb + ks); acc[nb] = __builtin_amdgcn_mfma_f32_16x16x32_bf16(bb, a, acc[nb], 0, 0, 0); }
    }
}
__device__ __forceinline__ void skinny_reduce(LAS unsigned char* lds, f32x4 (&acc)[4], int wave, int lane) {
    LAS float* red = (LAS float*)lds;
#pragma unroll
    for (int nb = 0; nb < 4; ++nb) *(LAS f32x4*)(red + ((wave * 64 + lane) * 16 + nb * 4)) = acc[nb];
    __syncthreads();
    if (wave == 0) {
#pragma unroll
        for (int nb = 0; nb < 4; ++nb) { f32x4 s = (f32x4){0.f, 0.f, 0.f, 0.f};
#pragma unroll
            for (int w = 0; w < 8; ++w) s += *(const LAS f32x4*)(red + ((w * 64 + lane) * 16 + nb * 4));
            acc[nb] = s; } }
    __syncthreads();
}
#define ZERO4(a) do { _Pragma("unroll") for (int z_ = 0; z_ < 4; ++z_) a[z_] = (f32x4){0.f, 0.f, 0.f, 0.f}; } while (0)

struct Args { const float* in[18]; float* out; unsigned char* ws; int ph_lo, ph_hi; };
#ifndef PROBE_DUP
#define PROBE_DUP -1
#endif
#ifndef PROBE_SYNCS
#define PROBE_SYNCS 1
#endif
constexpr int XST_OFF = 131072 + 64;
__global__ void __launch_bounds__(NTHR, 2) hybrid_fwd(Args args) {
    extern __shared__ __attribute__((aligned(16))) unsigned char lds_raw[];
    LAS unsigned char* lds = (LAS unsigned char*)lds_raw;
    const int tid = threadIdx.x, lane = tid & 63, wave = __builtin_amdgcn_readfirstlane(tid >> 6);
    const int G = gridDim.x, bx = blockIdx.x;
    const int gw = bx * NWAVES + wave, NGW = G * NWAVES;
    const int gt = bx * NTHR + tid, NGT = G * NTHR;
    unsigned char* ws = args.ws; float* out = args.out;
    const float *x_prompt = args.in[0], *x_sample = args.in[1], *state_pool = args.in[2], *state_hgrn = args.in[3], *meta = args.in[4], *g_mix = args.in[5], *w_in = args.in[6],
                *w_pool = args.in[7], *pool_scale = args.in[8], *lb_logits = args.in[9], *g_onorm = args.in[10], *w_a = args.in[11], *w_b = args.in[12], *w_out = args.in[13],
                *g_mlp = args.in[14], *w_up = args.in[15], *w_down = args.in[16], *g_final = args.in[17];
    float* LB = (float*)(ws + WS_LB); float* RSTD0 = (float*)(ws + WS_RSTD0); float* SS1 = (float*)(ws + WS_SS1); float* SS2 = (float*)(ws + WS_SS2);
    float* DVEC = (float*)(ws + WS_DVEC); float* DS0 = (float*)(ws + WS_DS0);
    bf16 *WIN = (bf16*)(ws + WS_WIN), *WAB = (bf16*)(ws + WS_WAB), *WOUT = (bf16*)(ws + WS_WOUT), *WUP = (bf16*)(ws + WS_WUP), *WDOWN = (bf16*)(ws + WS_WDOWN);
    bf16 *XB = (bf16*)(ws + WS_RA), *PO = (bf16*)(ws + WS_RA), *ON = PO + (size_t)M * PW, *X1B = (bf16*)(ws + WS_RA);
    bf16 *ST = (bf16*)(ws + WS_RS), *MB = (bf16*)(ws + WS_RS);
    bf16 *Z = (bf16*)(ws + WS_Z), *AB = (bf16*)(ws + WS_Z);
    const int lo = args.ph_lo, hi = args.ph_hi;
    if (tid < 2) ((volatile LAS unsigned*)(lds + XST_OFF))[tid] = 0u;
    __syncthreads();
    XcdBarrier bar; bar.bar = (unsigned*)(ws + WS_BAR); bar.x = 0; bar.st = nullptr;
    if (hi - lo > 1) bar = xcd_barrier_post((unsigned*)(ws + WS_BAR), (volatile LAS unsigned*)(lds + XST_OFF));
    if (hi > 1000) cg::this_grid().sync();
#define IN(k) (lo <= (k) && (k) < hi)
#define REP(k) for (int rep_ = 0; rep_ < ((k) == PROBE_DUP ? 2 : 1); ++rep_)
#define SEAM(k) do { if (IN(k) && IN((k) + 1)) for (int s_ = 0; s_ < PROBE_SYNCS; ++s_) xcd_barrier(bar); } while (0)
    const int sr = lane & 15, sq = lane >> 4;

    if (IN(0)) REP(0) {
        LAS float* scr = (LAS float*)(lds + wave * 16384);
        if (gt < PW) LB[gt] = frcp(1.0f + __expf(lb_logits[PW + gt] - lb_logits[gt]));
        constexpr int I_IN = (DM / 64) * (NIN / 32), I_B = (PW / 64) * (DM / 32), I_O = (DM / 64) * (DM / 32), I_UP = (DM / 64) * (FF / 32), I_DN = (FF / 64) * (DM / 32), I_FOLD = 1024;
        constexpr int NITEMS = I_IN + I_B + I_O + I_UP + I_DN + I_FOLD;
        for (int it = gw; it < NITEMS; it += NGW) {
            int r = it;
            if (r < I_IN) { p0_transpose_item(w_in, g_mix, DM, NIN, WIN, 0, scr, r, lane); continue; } r -= I_IN;
            if (r < I_B) { p0_transpose_item(w_b, nullptr, PW, DM, WAB, DM, scr, r, lane); continue; } r -= I_B;
            if (r < I_O) { p0_transpose_item(w_out, nullptr, DM, DM, WOUT, 0, scr, r, lane); continue; } r -= I_O;
            if (r < I_UP) { p0_transpose_item(w_up, g_mlp, DM, FF, WUP, 0, scr, r, lane); continue; } r -= I_UP;
            if (r < I_DN) { p0_transpose_item(w_down, nullptr, FF, DM, WDOWN, 0, scr, r, lane); continue; } r -= I_DN;
            p0_fold_item(w_pool, pool_scale, w_a, WAB, r, lane);
        }
        for (int m = gw; m < M; m += NGW) {
            const f32x4* xr = (const f32x4*)xin_full(x_prompt, x_sample, meta, m) + lane; f32x4 v[4]; float s = 0.f;
#pragma unroll
            for (int j = 0; j < 4; ++j) { v[j] = xr[64 * j]; s += (v[j][0] * v[j][0] + v[j][1] * v[j][1]) + (v[j][2] * v[j][2] + v[j][3] * v[j][3]); }
            s = wave_sum(s); if (lane == 0) RSTD0[m] = __builtin_amdgcn_rsqf(s * (1.0f / DM) + EPS);
            v2u* o8 = (v2u*)(XB + (size_t)m * DM) + lane;
#pragma unroll
            for (int j = 0; j < 4; ++j) { v2u o; o.x = pk2(v[j][0], v[j][1]); o.y = pk2(v[j][2], v[j][3]); o8[64 * j] = o; }
        }
        for (int i = gt; i < NSAMP * 14 * (PW / 4); i += NGT) {
            const int s = i / (14 * 128), rem = i - s * (14 * 128), j = rem >> 7, c4 = rem & 127;
            *(f32x4*)(out + OUT_NPS + ((size_t)s * 15 + j) * PW + c4 * 4) = *(const f32x4*)(state_pool + ((size_t)s * 15 + j + 1) * PW + c4 * 4);
        }
    }
    SEAM(0);
    if (IN(1)) REP(1) {
        pg8::Gemm g{XB, WIN, M, NIN, DM}; pg8::StaticOrder S; S.init(M, NIN, G, bx);
        Epi1 E{Z, RSTD0, LB, out};
        pg8::gemm_phase<Epi1, pg8::StaticOrder, true, true>(lds, g, S, E);
    }
    SEAM(1);
    if (IN(2)) REP(2) {
        for (int it = gt; it < MC * 64; it += NGT) {
            const int cr = it >> 6, c8 = it & 63, w = 2 << (c8 >> 4);
            const bf16* U = Z + (size_t)full_of_compact(cr) * NIN + ZU + c8 * 8;
            const v4u cur = *(const v4u*)U;
            const float u0 = bflo(cur.x), u1 = bfhi(cur.x), u2 = bflo(cur.y), u3 = bfhi(cur.y), u4 = bflo(cur.z), u5 = bfhi(cur.z), u6 = bflo(cur.w), u7 = bfhi(cur.w);
            float s0 = u0, s1 = u1, s2 = u2, s3 = u3, s4 = u4, s5 = u5, s6 = u6, s7 = u7;
            if (cr < MR) {
                for (int jj = 1; jj < w; ++jj) { const v4u p = *(const v4u*)(U - (size_t)jj * NIN);
                    s0 += bflo(p.x); s1 += bfhi(p.x); s2 += bflo(p.y); s3 += bfhi(p.y); s4 += bflo(p.z); s5 += bfhi(p.z); s6 += bflo(p.w); s7 += bfhi(p.w); }
            } else { const int sidx = cr - MR;
                for (int jj = 1; jj < w; ++jj) { const float* sp = state_pool + ((size_t)sidx * 15 + (15 - jj)) * PW + c8 * 8; const f32x4 a = *(const f32x4*)sp, bq = *(const f32x4*)(sp + 4);
                    s0 += a[0]; s1 += a[1]; s2 += a[2]; s3 += a[3]; s4 += bq[0]; s5 += bq[1]; s6 += bq[2]; s7 += bq[3]; }
            }
            const float inv = 1.0f / (float)w;
            v4u o; o.x = pk2(s0 * inv - u0, s1 * inv - u1); o.y = pk2(s2 * inv - u2, s3 * inv - u3); o.z = pk2(s4 * inv - u4, s5 * inv - u5); o.w = pk2(s6 * inv - u6, s7 * inv - u7);
            *(v4u*)(PO + (size_t)cr * PW + c8 * 8) = o;
        }
        for (int un = bx; un < NUNIT; un += G) { const int bh = un / NCH, c = un - bh * NCH;
            float* dS = c == 0 ? DS0 + (size_t)bh * 16384 : out + ((size_t)bh * 32 + (c - 1)) * 16384;
            scan_pass1_unit(lds, Z, dS, DVEC + (size_t)un * 128, bh >> 2, bh & 3, c, tid); }
    }
    SEAM(2);
    if (IN(3)) REP(3) {
        for (int e = gt; e < NBH * 4096; e += NGT) { const int bh = e >> 12, rem = e & 4095, v = rem >> 5, k4 = rem & 31;
            f32x4 S = (f32x4){0.f, 0.f, 0.f, 0.f}; const size_t eo = (size_t)v * 128 + k4 * 4;
#pragma unroll 4
            for (int c = 0; c < NCH; ++c) {
                const float* dsp = (c == 0 ? DS0 + (size_t)bh * 16384 : out + ((size_t)bh * 32 + (c - 1)) * 16384) + eo;
                const f32x4 d = *(const f32x4*)(DVEC + (size_t)(bh * NCH + c) * 128 + k4 * 4), ds = *(const f32x4*)dsp;
                v2u o; o.x = pk2(S[0], S[1]); o.y = pk2(S[2], S[3]); *(v2u*)(ST + (size_t)(bh * NCH + c) * 16384 + eo) = o;
                S = d * S + ds; }
            float* fo = out + OUT_NHP + (size_t)bh * 16384 + (size_t)(k4 * 4) * 128 + v;
            fo[0] = S[0]; fo[128] = S[1]; fo[256] = S[2]; fo[384] = S[3];
        }
        for (int un = bx; un < NSAMP * 4; un += G)
            sample_hgrn_unit(lds, Z, state_hgrn, out + OUT_NHS, g_onorm, ON, un >> 2, un & 3, tid);
    }
    SEAM(3);
    if (IN(4)) REP(4) {
        for (int un = bx; un < NBH * 32; un += G) { const int bh = un >> 5, c = (un & 31) + 1;
            scan_pass3_unit(lds, Z, ST + (size_t)(bh * NCH + c) * 16384, g_onorm, ON, bh >> 2, bh & 3, c, tid); }
    }
    SEAM(4);
    if (IN(5)) REP(5) {
        { pg8::Gemm g{PO, WAB, 2 * M, 2 * DM, PW}; PairOrder S{G, bx};
          Epi2 E{Z, MB};
          pg8::gemm_phase<Epi2, PairOrder, true, true>(lds, g, S, E); }
        for (int t = bx; t < 128; t += G) { const int row0 = MR + (t >> 4) * 16, n0 = (t & 15) * 64;
            f32x4 ya[4], yb[4]; ZERO4(ya); ZERO4(yb);
            skinny_mma(ya, PO, PW, WAB, PW, PW, row0, n0, wave, sr, sq); skinny_mma(yb, ON, PW, WAB + (size_t)DM * PW, PW, PW, row0, n0, wave, sr, sq);
            skinny_reduce(lds, ya, wave, lane); skinny_reduce(lds, yb, wave, lane);
            if (wave == 0) { const int cr = row0 + sr; const bf16* zr = Z + (size_t)full_of_compact(cr) * NIN;
#pragma unroll
                for (int nb = 0; nb < 4; ++nb) { const int col = n0 + 16 * nb + 4 * sq; const v2u ga = *(const v2u*)(zr + ZGA + col), gb = *(const v2u*)(zr + ZGB + col);
                    v2u o; o.x = pk2(bflo(ga.x) * ya[nb][0] + bflo(gb.x) * yb[nb][0], bfhi(ga.x) * ya[nb][1] + bfhi(gb.x) * yb[nb][1]);
                    o.y = pk2(bflo(ga.y) * ya[nb][2] + bflo(gb.y) * yb[nb][2], bfhi(ga.y) * ya[nb][3] + bfhi(gb.y) * yb[nb][3]);
                    *(v2u*)(MB + (size_t)cr * DM + col) = o; } }
        }
    }
    SEAM(5);
    if (IN(6)) REP(6) {
        { pg8::Gemm g{MB, WOUT, MR, DM, DM}; pg8::StaticOrder S; S.init(MR, DM, G, bx);
          Epi3 E{x_prompt, out, X1B, SS1};
          pg8::gemm_phase<Epi3, pg8::StaticOrder, true, true>(lds, g, S, E); }
        for (int t = bx; t < 128; t += G) { const int row0 = MR + (t >> 4) * 16, n0 = (t & 15) * 64;
            f32x4 acc[4]; ZERO4(acc);
            skinny_mma(acc, MB, DM, WOUT, DM, DM, row0, n0, wave, sr, sq); skinny_reduce(lds, acc, wave, lane);
            if (wave == 0) { const int cr = row0 + sr; const float* xi = x_sample + (size_t)(cr - MR) * DM; float s = 0.f;
#pragma unroll
                for (int nb = 0; nb < 4; ++nb) { const int col = n0 + 16 * nb + 4 * sq; const f32x4 v = *(const f32x4*)(xi + col) + acc[nb];
                    *(f32x4*)(out + (size_t)cr * DM + col) = v; s += (v[0] * v[0] + v[1] * v[1]) + (v[2] * v[2] + v[3] * v[3]);
                    v2u o; o.x = pk2(v[0], v[1]); o.y = pk2(v[2], v[3]); *(v2u*)(X1B + (size_t)cr * DM + col) = o; }
                s += __shfl_xor(s, 16); s += __shfl_xor(s, 32);
                if (sq == 0) SS1[(size_t)(t & 15) * M + cr] = s; }
        }
    }
    SEAM(6);
    if (IN(7)) REP(7) {
        { pg8::Gemm g{X1B, WUP, MR, FF, DM}; pg8::StaticOrder S; S.init(MR, FF, G, bx);
          Epi4 E{AB, SS1};
          pg8::gemm_phase<Epi4, pg8::StaticOrder, true, true>(lds, g, S, E); }
        for (int t = bx; t < 512; t += G) { const int row0 = MR + (t >> 6) * 16, n0 = (t & 63) * 64;
            f32x4 acc[4]; ZERO4(acc);
            skinny_mma(acc, X1B, DM, WUP, DM, DM, row0, n0, wave, sr, sq); skinny_reduce(lds, acc, wave, lane);
            if (wave == 0) { const int cr = row0 + sr; const float rs = rstd_from_parts(SS1, cr);
#pragma unroll
                for (int nb = 0; nb < 4; ++nb) { const int col = n0 + 16 * nb + 4 * sq; f32x4 v = acc[nb] * rs;
#pragma unroll
                    for (int e = 0; e < 4; ++e) { const float a = fmaxf(v[e], 0.f); v[e] = a * a; }
                    v2u o; o.x = pk2(v[0], v[1]); o.y = pk2(v[2], v[3]); *(v2u*)(AB + (size_t)cr * FF + col) = o; } }
        }
    }
    SEAM(7);
    if (IN(8)) REP(8) {
        { pg8::Gemm g{AB, WDOWN, MR, DM, FF}; pg8::StaticOrder S; S.init(MR, DM, G, bx);
          Epi5 E{out, SS2};
          pg8::gemm_phase<Epi5, pg8::StaticOrder, true, true>(lds, g, S, E); }
        for (int t = bx; t < 128; t += G) { const int row0 = MR + (t >> 4) * 16, n0 = (t & 15) * 64;
            f32x4 acc[4]; ZERO4(acc);
            skinny_mma(acc, AB, FF, WDOWN, FF, FF, row0, n0, wave, sr, sq); skinny_reduce(lds, acc, wave, lane);
            if (wave == 0) { const int cr = row0 + sr; float s = 0.f;
#pragma unroll
                for (int nb = 0; nb < 4; ++nb) { const int col = n0 + 16 * nb + 4 * sq; float* xo = out + (size_t)cr * DM + col; const f32x4 v = *(const f32x4*)xo + acc[nb];
                    *(f32x4*)xo = v; s += (v[0] * v[0] + v[1] * v[1]) + (v[2] * v[2] + v[3] * v[3]); }
                s += __shfl_xor(s, 16); s += __shfl_xor(s, 32);
                if (sq == 0) SS2[(size_t)(t & 15) * M + cr] = s; }
        }
    }
    SEAM(8);
    if (IN(9)) REP(9) {
        for (int m = gw; m < MC; m += NGW) {
            const float rs = rstd_from_parts(SS2, m);
            f32x4* xr = (f32x4*)(out + (size_t)m * DM) + lane; const f32x4* gf = (const f32x4*)g_final + lane;
#pragma unroll
            for (int j = 0; j < 4; ++j) xr[64 * j] = xr[64 * j] * rs * gf[64 * j];
        }
    }
#undef IN
#undef SEAM
}

extern "C" void kernel_launch(void* const* d_in, const int* in_sizes, int n_in, void* d_out, int out_size, void* d_ws, size_t ws_size, hipStream_t stream) {
    static int grid = 0;
    if (grid == 0) {
        if (n_in != 18 || (size_t)out_size != OUT_END || ws_size < WS_END) { fprintf(stderr, "kernel_launch: unexpected shapes (n_in %d out %d ws %zu)\n", n_in, out_size, ws_size); grid = -1; return; }
        int dev = 0, cus = 0, per_cu = 0;
        (void)hipGetDevice(&dev); (void)hipDeviceGetAttribute(&cus, hipDeviceAttributeMultiprocessorCount, dev);
        if (hipFuncSetAttribute((const void*)hybrid_fwd, hipFuncAttributeMaxDynamicSharedMemorySize, LDS_BYTES) != hipSuccess) { fprintf(stderr, "kernel_launch: hipFuncSetAttribute failed\n"); grid = -1; return; }
        if (hipOccupancyMaxActiveBlocksPerMultiprocessor(&per_cu, (const void*)hybrid_fwd, NTHR, LDS_BYTES) != hipSuccess || per_cu < 1) { fprintf(stderr, "kernel_launch: occupancy query says %d\n", per_cu); per_cu = 1; }
        (void)hipGetLastError();
        grid = cus * 1;
        if (grid <= 0) grid = 256;
    }
    if (grid < 0) return;
    (void)hipMemsetAsync((unsigned char*)d_ws + WS_BAR, 0, XCD_BAR_WORDS * 4, stream);
    Args a{};
    for (int i = 0; i < 18; ++i) a.in[i] = (const float*)d_in[i];
    a.out = (float*)d_out; a.ws = (unsigned char*)d_ws;
#if MK_N_LAUNCHES == 1
    a.ph_lo = 0; a.ph_hi = NPHASE;
    void* kargs[] = {&a};
    hipError_t e = hipLaunchCooperativeKernel((const void*)hybrid_fwd, dim3(grid), dim3(NTHR), kargs, LDS_BYTES, stream);
    if (e != hipSuccess) fprintf(stderr, "kernel_launch: cooperative launch failed: %s (grid %d)\n", hipGetErrorString(e), grid);
#else
    for (int p = 0; p < NPHASE; ++p) { a.ph_lo = p; a.ph_hi = p + 1; hipLaunchKernelGGL(hybrid_fwd, dim3(grid), dim3(NTHR), LDS_BYTES, stream, a); }
#endif
}
```

```cpp
#include <hip/hip_runtime.h>
#include <hip/hip_cooperative_groups.h>
#include <cstdio>
#include <cstdint>
namespace cg = cooperative_groups;
namespace pg8 {
#define PG8_LAS __attribute__((address_space(3)))
typedef unsigned short bf16_t;
typedef short bf16x8 __attribute__((ext_vector_type(8)));
typedef float f32x4 __attribute__((ext_vector_type(4)));
typedef unsigned u32x4 __attribute__((ext_vector_type(4)));
constexpr int BM = 256, BK = 64, HALF = 128, HTB = HALF * BK * 2  , STAGE_BYTES = 8 * HTB, NXCD = 8, WGM = 8;

__host__ __device__ __forceinline__ int lds_byte(int r, int c) { const int st = (r >> 4) * 2 + (c >> 5), rr = r & 15, cc = c & 31, ob = rr * 64 + cc * 2; return st * 1024 + (ob ^ (((ob >> 9) & 1) << 5)); }
__host__ __device__ __forceinline__ void stage_rc(int b, int& R, int& C) { const int st = b / 1024, sb = b % 1024, swz = sb ^ (((sb >> 9) & 1) << 5); R = (st >> 1) * 16 + swz / 64; C = (st & 1) * 32 + (swz % 64) / 2; }
__host__ __device__ __forceinline__ int perm32(int rho) { const int n = rho >> 4, i = rho & 15; return 8 * (i >> 2) + 4 * n + (i & 3); }

struct Unit { int pm, pn; };
struct Gemm { const bf16_t* A; const bf16_t* Bt; int M, N, K; };

struct StaticOrder {
    int nM, nN, nwg, G, c;
    __host__ __device__ void init(int M, int N, int G_, int c_) { nM = M / BM; nN = N / BM; nwg = nM * nN; G = G_; c = c_; }
    __host__ __device__ bool next(int i, Unit& u) const {
        const long L = (long)i * G + c; if (L >= nwg) return false;
        int wgid = (int)L; { const int q = nwg / NXCD, r = nwg % NXCD, xcd = wgid % NXCD, off = wgid / NXCD; wgid = (xcd < r ? xcd * (q + 1) : r * (q + 1) + (xcd - r) * q) + off; }
        const int nig = WGM * nN, gid = wgid / nig, fm = gid * WGM, gsz = (nM - fm) < WGM ? (nM - fm) : WGM;
        u.pm = fm + ((wgid % nig) % gsz); u.pn = (wgid % nig) / gsz; return true;
    }
    __device__ __forceinline__ void a_ready(const Unit&) const {}
    __device__ __forceinline__ void done(const Unit&) const {}
};

__device__ __forceinline__ unsigned cvt_pk_bf16(float lo, float hi) { unsigned r; asm volatile("v_cvt_pk_bf16_f32 %0, %1, %2" : "=v"(r) : "v"(lo), "v"(hi)); return r; }
typedef float f32x2 __attribute__((ext_vector_type(2)));
template <class Epi, class Sched, bool ALIGN_EPI = false, bool SP2 = false>
__device__ __forceinline__ void gemm_phase(PG8_LAS unsigned char* lds, const Gemm g, const Sched& S, const Epi& E) {
    const int tid = threadIdx.x, wid = __builtin_amdgcn_readfirstlane(tid >> 6), lane = tid & 63, wr = wid >> 2, wc = wid & 3, fr = lane & 15, fq = lane >> 4;
    const int K = g.K, nt = K / BK;
    unsigned voffA[2], voffB[2];
#pragma unroll
    for (int i = 0; i < 2; ++i) { int R, C; stage_rc(tid * 16 + i * 8192, R, C); const int Rb = Epi::PERM ? ((R & ~31) + perm32(R & 31)) : R;
        voffA[i] = (unsigned)(R * K + C) * 2u; voffB[i] = (unsigned)(Rb * K + C) * 2u; }
    const size_t kstep = (size_t)(BK * 2);
    const size_t hstep = (size_t)HALF * K * 2;
    const size_t tstep = 2 * hstep;
    const unsigned ldsw = (unsigned)wid * 1024u;
    const int aoff = lds_byte(wr * 64 + fr, fq * 8), boff = lds_byte(wc * 32 + fr, fq * 8);
#define PG8_SA(b, h) (((b) * 2 + (h)) * HTB)
#define PG8_SB(b, h) ((4 + (b) * 2 + (h)) * HTB)
#define PG8_STAGE(bufoff, gbase, voff) do { _Pragma("unroll") for (int _i = 0; _i < 2; ++_i) \
        __builtin_amdgcn_global_load_lds((const unsigned*)((const char*)(gbase) + (voff)[_i]), (PG8_LAS unsigned*)(lds + (bufoff) + ldsw + _i * 8192), 16, 0, 0); } while (0)
#define PG8_LDA(dst, b, h) do { _Pragma("unroll") for (int m = 0; m < 4; ++m) _Pragma("unroll") for (int k = 0; k < 2; ++k) dst[m][k] = *(const PG8_LAS bf16x8*)(lds + PG8_SA(b, h) + aoff + m * 2048 + k * 1024); } while (0)
#define PG8_LDB(dst, b, h) do { _Pragma("unroll") for (int n = 0; n < 2; ++n) _Pragma("unroll") for (int k = 0; k < 2; ++k) dst[n][k] = *(const PG8_LAS bf16x8*)(lds + PG8_SB(b, h) + boff + n * 2048 + k * 1024); } while (0)
#define PG8_MMA(ai, bj, At, Bt) do { __builtin_amdgcn_s_setprio(1); _Pragma("unroll") for (int m = 0; m < 4; ++m) _Pragma("unroll") for (int n = 0; n < 2; ++n) _Pragma("unroll") for (int k = 0; k < 2; ++k) \
        acc[ai][bj][m][n] = __builtin_amdgcn_mfma_f32_16x16x32_bf16(Bt[n][k], At[m][k], acc[ai][bj][m][n], 0, 0, 0); __builtin_amdgcn_s_setprio(0); } while (0)
#define PG8_WAIT_V(n) asm volatile("s_waitcnt vmcnt(" #n ")" ::: "memory")
#define PG8_WAIT_L(n) asm volatile("s_waitcnt lgkmcnt(" #n ")" ::: "memory")
#define PG8_BAR __builtin_amdgcn_s_barrier()
#define PG8_SCHED __builtin_amdgcn_sched_barrier(0)
    Unit cur, nxt; int ui = 0;
    if (!S.next(0, cur)) return;
    f32x4 acc[2][2][4][2];
#pragma unroll
    for (int a = 0; a < 2; ++a)
#pragma unroll
        for (int b = 0; b < 2; ++b)
#pragma unroll
            for (int m = 0; m < 4; ++m)
#pragma unroll
                for (int n = 0; n < 2; ++n) acc[a][b][m][n] = (f32x4){0.f, 0.f, 0.f, 0.f};
    bf16x8 At[4][2], B0[2][2], B1[2][2];
    const char* cA = (const char*)g.A + (size_t)cur.pm * tstep; const char* cB = (const char*)g.Bt + (size_t)cur.pn * tstep;
    S.a_ready(cur);
    if constexpr (SP2) {
        PG8_STAGE(PG8_SB(0, 0), cB, voffB); PG8_STAGE(PG8_SB(0, 1), cB + hstep, voffB); PG8_STAGE(PG8_SA(0, 0), cA, voffA); PG8_STAGE(PG8_SA(0, 1), cA + hstep, voffA);
        if (wr == 1) PG8_BAR;
        PG8_WAIT_V(2); PG8_BAR;
        PG8_STAGE(PG8_SB(1, 0), cB + kstep, voffB); PG8_STAGE(PG8_SA(1, 0), cA + kstep, voffA); PG8_STAGE(PG8_SB(1, 1), cB + hstep + kstep, voffB);
        PG8_WAIT_V(6); PG8_BAR;
    } else {
        PG8_STAGE(PG8_SB(0, 0), cB, voffB); PG8_STAGE(PG8_SA(0, 0), cA, voffA); PG8_STAGE(PG8_SB(0, 1), cB + hstep, voffB); PG8_STAGE(PG8_SA(0, 1), cA + hstep, voffA);
        if (wr == 1) PG8_BAR;
        PG8_WAIT_V(4); PG8_BAR;
        PG8_STAGE(PG8_SB(1, 0), cB + kstep, voffB); PG8_STAGE(PG8_SA(1, 0), cA + kstep, voffA); PG8_STAGE(PG8_SB(1, 1), cB + hstep + kstep, voffB);
        PG8_WAIT_V(6); PG8_BAR;
    }
    for (;;) {
        const bool has_next = S.next(ui + 1, nxt);
        const char* nA = has_next ? (const char*)g.A + (size_t)nxt.pm * tstep : cA; const char* nB = has_next ? (const char*)g.Bt + (size_t)nxt.pn * tstep : cB;
        for (int t = 0; t < nt; t += 2) {
            const bool last = (t == nt - 2);
            const char* a1 = cA + (size_t)(t + 1) * kstep;
            const char* a2 = last ? nA : cA + (size_t)(t + 2) * kstep; const char* b2 = last ? nB : cB + (size_t)(t + 2) * kstep;
            const char* a3 = a2 + kstep; const char* b3 = b2 + kstep;
            if (last && has_next) S.a_ready(nxt);
            if constexpr (SP2) {
            PG8_LDB(B0, 0, 0); PG8_LDB(B1, 0, 1); PG8_SCHED; PG8_LDA(At, 0, 0); PG8_STAGE(PG8_SA(1, 1), a1 + hstep, voffA);
            PG8_WAIT_V(8); PG8_WAIT_L(0); PG8_BAR; PG8_MMA(0, 0, At, B0); PG8_MMA(0, 1, At, B1); PG8_BAR; PG8_SCHED;
            PG8_LDA(At, 0, 1); PG8_STAGE(PG8_SB(0, 0), b2, voffB); PG8_STAGE(PG8_SB(0, 1), b2 + hstep, voffB); PG8_STAGE(PG8_SA(0, 0), a2, voffA);
            PG8_WAIT_V(8); PG8_WAIT_L(0); PG8_BAR; PG8_MMA(1, 0, At, B0); PG8_MMA(1, 1, At, B1); PG8_BAR; PG8_SCHED;
            PG8_LDB(B0, 1, 0); PG8_LDB(B1, 1, 1); PG8_SCHED; PG8_LDA(At, 1, 0); PG8_STAGE(PG8_SA(0, 1), a2 + hstep, voffA);
            PG8_WAIT_V(8); PG8_WAIT_L(0); PG8_BAR; PG8_MMA(0, 0, At, B0); PG8_MMA(0, 1, At, B1); PG8_BAR; PG8_SCHED;
            PG8_LDA(At, 1, 1); PG8_STAGE(PG8_SB(1, 0), b3, voffB); PG8_STAGE(PG8_SB(1, 1), b3 + hstep, voffB); PG8_STAGE(PG8_SA(1, 0), a3, voffA);
            PG8_WAIT_V(8); PG8_WAIT_L(0); PG8_BAR; PG8_MMA(1, 0, At, B0); PG8_MMA(1, 1, At, B1); PG8_BAR; PG8_SCHED;
            } else {
            PG8_LDB(B0, 0, 0); PG8_SCHED; PG8_LDA(At, 0, 0); PG8_STAGE(PG8_SA(1, 1), a1 + hstep, voffA);
            PG8_WAIT_L(8); PG8_BAR; PG8_WAIT_L(0); PG8_MMA(0, 0, At, B0); PG8_BAR; PG8_SCHED;
            PG8_LDB(B1, 0, 1); PG8_STAGE(PG8_SB(0, 0), b2, voffB);
            PG8_BAR; PG8_WAIT_L(0); PG8_MMA(0, 1, At, B1); PG8_BAR;
            PG8_LDA(At, 0, 1); PG8_STAGE(PG8_SA(0, 0), a2, voffA);
            PG8_BAR; PG8_WAIT_L(0); PG8_MMA(1, 0, At, B0); PG8_BAR; PG8_SCHED;
            PG8_STAGE(PG8_SB(0, 1), b2 + hstep, voffB);
            PG8_WAIT_V(6); PG8_BAR; PG8_MMA(1, 1, At, B1); PG8_BAR;
            PG8_LDB(B0, 1, 0); PG8_SCHED; PG8_LDA(At, 1, 0); PG8_STAGE(PG8_SA(0, 1), a2 + hstep, voffA);
            PG8_WAIT_L(8); PG8_BAR; PG8_WAIT_L(0); PG8_MMA(0, 0, At, B0); PG8_BAR; PG8_SCHED;
            PG8_LDB(B1, 1, 1); PG8_STAGE(PG8_SB(1, 0), b3, voffB);
            PG8_BAR; PG8_WAIT_L(0); PG8_MMA(0, 1, At, B1); PG8_BAR;
            PG8_LDA(At, 1, 1); PG8_STAGE(PG8_SA(1, 0), a3, voffA);
            PG8_BAR; PG8_WAIT_L(0); PG8_MMA(1, 0, At, B0); PG8_BAR; PG8_SCHED;
            PG8_STAGE(PG8_SB(1, 1), b3 + hstep, voffB);
            PG8_WAIT_V(6); PG8_BAR; PG8_MMA(1, 1, At, B1); PG8_BAR;
            }
        }
        if constexpr (ALIGN_EPI) { if (wr == 0) PG8_BAR; }
        if constexpr (!Epi::AFTER_DRAIN) { E(acc, cur, wr, wc, fr, fq); S.done(cur); }
        if (!has_next) break;
#pragma unroll
        for (int a = 0; a < 2; ++a)
#pragma unroll
            for (int b = 0; b < 2; ++b)
#pragma unroll
                for (int m = 0; m < 4; ++m)
#pragma unroll
                    for (int n = 0; n < 2; ++n) acc[a][b][m][n] = (f32x4){0.f, 0.f, 0.f, 0.f};
        cur = nxt; cA = nA; cB = nB; ++ui;
        if constexpr (ALIGN_EPI) { if (wr == 1) PG8_BAR; }
    }
    PG8_WAIT_V(0);
    if constexpr (!ALIGN_EPI) { if (wr == 0) PG8_BAR; }
    PG8_BAR;
    if constexpr (Epi::AFTER_DRAIN) { E.fused(acc, cur, wr, wc, fr, fq, lds, wid, lane); S.done(cur); }
#undef PG8_SA
#undef PG8_SB
#undef PG8_STAGE
#undef PG8_LDA
#undef PG8_LDB
#undef PG8_MMA
#undef PG8_WAIT_V
#undef PG8_WAIT_L
#undef PG8_BAR
#undef PG8_SCHED
}
}

#define GAS __attribute__((address_space(1)))
#define LAS __attribute__((address_space(3)))
typedef unsigned short bf16;
typedef unsigned v4u __attribute__((ext_vector_type(4)));
typedef unsigned v2u __attribute__((ext_vector_type(2)));
typedef float f32x4 __attribute__((ext_vector_type(4)));
typedef short bf16x8 __attribute__((ext_vector_type(8)));
using pg8::Unit;

#ifndef MK_N_LAUNCHES
#define MK_N_LAUNCHES 1
#endif
constexpr int NPHASE = 9;
constexpr int NWAVES = 8, NTHR = 512;
constexpr int DM = 1024, NB = 8, SEQ = 2048, NMETA = 16, LP = SEQ + NMETA, NSAMP = 128;
constexpr int MP = NB * LP, M = MP + NSAMP, NMT = M / 256;
constexpr int MR = NB * SEQ, MC = MR + NSAMP, NRT = MR / 256;
constexpr int NIN = 4608, FF = 4096, PW = 512;
constexpr int NCH = 33, PADT = 48, NBH = 32, NUNIT = NBH * NCH;
constexpr float EPS = 1e-6f;
constexpr int ZU = 0, ZQ = 512, ZF = 1024, ZV = 1536, ZOG = 2048, ZGA = 2560, ZGB = 3584;
constexpr size_t OUT_YP = 0, OUT_YS = (size_t)NB * SEQ * DM, OUT_NPP = OUT_YS + (size_t)NSAMP * DM, OUT_NHP = OUT_NPP + (size_t)NB * 15 * PW,
                 OUT_NPS = OUT_NHP + (size_t)NB * 4 * 16384, OUT_NHS = OUT_NPS + (size_t)NSAMP * 15 * PW, OUT_END = OUT_NHS + (size_t)NSAMP * 4 * 16384;
constexpr size_t MiB = 1u << 20;
constexpr size_t WS_LB = 0, WS_RSTD0 = 64 * 1024, WS_SS1 = 256 * 1024, WS_SS2 = 1536 * 1024, WS_DVEC = 3 * MiB, WS_DS0 = 5 * MiB, WS_BAR = 7 * MiB;
constexpr size_t WS_WIN = 8 * MiB, WS_WAB = 17 * MiB, WS_WOUT = 19 * MiB, WS_WUP = 21 * MiB, WS_WDOWN = 29 * MiB;
constexpr size_t WS_RA = 37 * MiB;
constexpr size_t WS_RS = 70 * MiB;
constexpr size_t WS_Z = 103 * MiB;
constexpr size_t WS_END = 250 * MiB;
static_assert(WS_RA + (size_t)M * DM * 2 <= WS_RS && WS_RS + (size_t)NUNIT * 32768 <= WS_Z && WS_Z + (size_t)M * NIN * 2 <= WS_END, "ws map");
static_assert(WS_SS1 + 16 * (size_t)M * 4 <= WS_SS2 && WS_SS2 + 16 * (size_t)M * 4 <= WS_DVEC && WS_DVEC + (size_t)NUNIT * 512 <= WS_DS0, "ws small map");
constexpr int LDS_BYTES = 147456;

#define LDS_WAIT() asm volatile("s_waitcnt lgkmcnt(0)" ::: "memory")
__device__ __forceinline__ unsigned f2bf(float f) { unsigned u = __builtin_bit_cast(unsigned, f); return (u + 0x7fffu + ((u >> 16) & 1u)) >> 16; }
typedef float f32x2c __attribute__((ext_vector_type(2)));
typedef __bf16 bf16x2c __attribute__((ext_vector_type(2)));
__device__ __forceinline__ unsigned pk2(float lo, float hi) { const f32x2c v = {lo, hi}; return __builtin_bit_cast(unsigned, __builtin_convertvector(v, bf16x2c)); }
__device__ __forceinline__ float bflo(unsigned u) { return __builtin_bit_cast(float, u << 16); }
__device__ __forceinline__ float bfhi(unsigned u) { return __builtin_bit_cast(float, u & 0xffff0000u); }
__device__ __forceinline__ float bf1(unsigned short u) { return __builtin_bit_cast(float, (unsigned)u << 16); }
__device__ __forceinline__ float h1(unsigned short u) { return (float)__builtin_bit_cast(_Float16, u); }
__device__ __forceinline__ unsigned pkh2(float lo, float hi) { const _Float16 a = (_Float16)lo, b = (_Float16)hi; return (unsigned)__builtin_bit_cast(unsigned short, a) | ((unsigned)__builtin_bit_cast(unsigned short, b) << 16); }
__device__ __forceinline__ float frcp(float x) { return __builtin_amdgcn_rcpf(x); }
__device__ __forceinline__ float sigm(float x) { return frcp(1.0f + __expf(-x)); }
__device__ __forceinline__ float wave_sum(float v) {
#pragma unroll
    for (int o = 1; o < 64; o <<= 1) v += __shfl_xor(v, o);
    return v;
}
__device__ __forceinline__ const float* xin_full(const float* xp, const float* xs, const float* meta, int r) {
    if (r >= MP) return xs + (size_t)(r - MP) * DM;
    const int b = r / LP, t = r - b * LP;
    return t < NMETA ? meta + (size_t)t * DM : xp + ((size_t)b * SEQ + (t - NMETA)) * DM;
}
__device__ __forceinline__ int full_of_compact(int cr) { return cr < MR ? (cr >> 11) * LP + NMETA + (cr & (SEQ - 1)) : cr + (MP - MR); }

struct Epi1 {
    static constexpr bool PERM = true, AFTER_DRAIN = false;
    bf16* Z; const float* rstd0; const float* lb; float* out; bf16* KT; bf16* VT;
    __device__ __forceinline__ void operator()(const f32x4 (&acc)[2][2][4][2], const Unit& u, int wr, int wc, int fr, int fq) const {
        const int row0 = u.pm * 256 + wr * 64 + fr, colb = u.pn * 256 + wc * 32 + 8 * fq;
        const int type = u.pn < 10 ? (u.pn >> 1) : (u.pn < 14 ? 5 : 6);
#pragma unroll
        for (int ai = 0; ai < 2; ++ai)
#pragma unroll
            for (int m = 0; m < 4; ++m) {
                const int row = row0 + ai * 128 + m * 16; const float rs = rstd0[row];
                bf16* zr = Z + (size_t)row * NIN;
                const int b = row / LP, t = row - b * LP;
                float* pdst = nullptr;
                if (type == 0) { if (row >= MP) pdst = out + OUT_NPS + ((size_t)(row - MP) * 15 + 14) * PW; else if (t >= LP - 15) pdst = out + OUT_NPP + ((size_t)b * 15 + (t - (LP - 15))) * PW; }
                const int tv = t + PADT; const size_t tbase = (((size_t)(b * 4) * NCH + (tv >> 6)) * 4 + ((tv >> 4) & 3)) * 2048 + (tv & 15);
#pragma unroll
                for (int bj = 0; bj < 2; ++bj) {
                    const int col = colb + bj * 128;
                    f32x4 v0 = acc[ai][bj][m][0] * rs, v1 = acc[ai][bj][m][1] * rs; v4u w;
                    if (type == 0 || type == 3) {
                        if (pdst) { *(f32x4*)(pdst + col) = v0; *(f32x4*)(pdst + col + 4) = v1; }
                        w.x = pk2(v0[0], v0[1]); w.y = pk2(v0[2], v0[3]); w.z = pk2(v1[0], v1[1]); w.w = pk2(v1[2], v1[3]);
                    } else if (type == 2) {
                        const f32x4 l0 = *(const f32x4*)(lb + col - ZF), l1 = *(const f32x4*)(lb + col - ZF + 4);
#pragma unroll
                        for (int e = 0; e < 4; ++e) { v0[e] = (1.0f - l0[e]) * sigm(-v0[e]); v1[e] = (1.0f - l1[e]) * sigm(-v1[e]); }
                        w.x = pkh2(v0[0], v0[1]); w.y = pkh2(v0[2], v0[3]); w.z = pkh2(v1[0], v1[1]); w.w = pkh2(v1[2], v1[3]);
                    } else {
#pragma unroll
                        for (int e = 0; e < 4; ++e) { const float s0 = sigm(v0[e]), s1 = sigm(v1[e]); v0[e] = type >= 5 ? s0 : v0[e] * s0; v1[e] = type >= 5 ? s1 : v1[e] * s1; }
                        w.x = pk2(v0[0], v0[1]); w.y = pk2(v0[2], v0[3]); w.z = pk2(v1[0], v1[1]); w.w = pk2(v1[2], v1[3]);
                    }
                    if (type != 3 || row >= MP) *(v4u*)(zr + col) = w;
                    if ((type == 2 || type == 3) && row < MP) {
                        const int hh = 2 * (u.pn & 1) + bj, ch = wc * 32 + 8 * fq;
                        bf16* d = (type == 2 ? KT : VT) + tbase + (size_t)hh * NCH * 8192 + (size_t)ch * 16;
                        d[0] = (bf16)w.x; d[16] = (bf16)(w.x >> 16); d[32] = (bf16)w.y; d[48] = (bf16)(w.y >> 16); d[64] = (bf16)w.z; d[80] = (bf16)(w.z >> 16); d[96] = (bf16)w.w; d[112] = (bf16)(w.w >> 16);
                    }
                }
            }
    }
};
struct PairOrder {
    int G, c;
    __device__ bool next(int i, Unit& u) const { const int L = (i >> 1) * G + c; if (L >= NRT * 4) return false; const int half = i & 1; u.pm = (L >> 2) + half * NMT; u.pn = (L & 3) + half * 4; return true; }
    __device__ __forceinline__ void a_ready(const Unit&) const {}
    __device__ __forceinline__ void done(const Unit&) const {}
};
struct Epi2 {
    static constexpr bool PERM = false, AFTER_DRAIN = false;
    const bf16* Z; bf16* MB;
    __device__ __forceinline__ void operator()(const f32x4 (&acc)[2][2][4][2], const Unit& u, int wr, int wc, int fr, int fq) const {
        const int half = u.pm >= NMT ? 1 : 0;
        const int row0 = (u.pm - half * NMT) * 256 + wr * 64 + fr, colb = (u.pn - half * 4) * 256 + wc * 32 + 4 * fq;
        const int zoff = half ? ZGB : ZGA;
#pragma unroll
        for (int ai = 0; ai < 2; ++ai)
#pragma unroll
            for (int m = 0; m < 4; ++m) {
                const int row = row0 + ai * 128 + m * 16; const bf16* zr = Z + (size_t)full_of_compact(row) * NIN + zoff; bf16* mr = MB + (size_t)row * DM;
#pragma unroll
                for (int bj = 0; bj < 2; ++bj)
#pragma unroll
                    for (int n = 0; n < 2; ++n) {
                        const int col = colb + bj * 128 + n * 16;
                        const v2u g = *(const v2u*)(zr + col); const f32x4 a = acc[ai][bj][m][n];
                        float r0 = bflo(g.x) * a[0], r1 = bfhi(g.x) * a[1], r2 = bflo(g.y) * a[2], r3 = bfhi(g.y) * a[3];
                        if (half) { const v2u t = *(const v2u*)(mr + col); r0 += bflo(t.x); r1 += bfhi(t.x); r2 += bflo(t.y); r3 += bfhi(t.y); }
                        v2u o; o.x = pk2(r0, r1); o.y = pk2(r2, r3); *(v2u*)(mr + col) = o;
                    }
            }
    }
};
struct Epi3 {
    static constexpr bool PERM = false, AFTER_DRAIN = false;
    const float* xp; float* out; bf16* X1B; float* SS;
    __device__ __forceinline__ void operator()(const f32x4 (&acc)[2][2][4][2], const Unit& u, int wr, int wc, int fr, int fq) const {
        const int row0 = u.pm * 256 + wr * 64 + fr, colb = u.pn * 256 + wc * 32 + 4 * fq;
#pragma unroll
        for (int ai = 0; ai < 2; ++ai)
#pragma unroll
            for (int m = 0; m < 4; ++m) {
                const int row = row0 + ai * 128 + m * 16; const float* xi = xp + (size_t)row * DM; float* xo = out + (size_t)row * DM; bf16* xb = X1B + (size_t)row * DM;
                float s = 0.f;
#pragma unroll
                for (int bj = 0; bj < 2; ++bj)
#pragma unroll
                    for (int n = 0; n < 2; ++n) {
                        const int col = colb + bj * 128 + n * 16;
                        const f32x4 v = *(const f32x4*)(xi + col) + acc[ai][bj][m][n];
                        *(f32x4*)(xo + col) = v; s += (v[0] * v[0] + v[1] * v[1]) + (v[2] * v[2] + v[3] * v[3]);
                        v2u o; o.x = pk2(v[0], v[1]); o.y = pk2(v[2], v[3]); *(v2u*)(xb + col) = o;
                    }
                s += __shfl_xor(s, 16); s += __shfl_xor(s, 32);
                if (fq == 0) SS[(size_t)(u.pn * 4 + wc) * M + row] = s;
            }
    }
};
__device__ __forceinline__ float rstd_from_parts(const float* SS, int row) {
    float s = 0.f;
#pragma unroll
    for (int p = 0; p < 16; ++p) s += SS[(size_t)p * M + row];
    return __builtin_amdgcn_rsqf(s * (1.0f / DM) + EPS);
}
struct Epi4 {
    static constexpr bool PERM = true, AFTER_DRAIN = false;
    bf16* AB; const float* SS;
    __device__ __forceinline__ void operator()(const f32x4 (&acc)[2][2][4][2], const Unit& u, int wr, int wc, int fr, int fq) const {
        const int row0 = u.pm * 256 + wr * 64 + fr, colb = u.pn * 256 + wc * 32 + 8 * fq;
#pragma unroll
        for (int ai = 0; ai < 2; ++ai)
#pragma unroll
            for (int m = 0; m < 4; ++m) {
                const int row = row0 + ai * 128 + m * 16; const float rs = rstd_from_parts(SS, row); bf16* ar = AB + (size_t)row * FF;
#pragma unroll
                for (int bj = 0; bj < 2; ++bj) {
                    f32x4 v0 = acc[ai][bj][m][0] * rs, v1 = acc[ai][bj][m][1] * rs;
#pragma unroll
                    for (int e = 0; e < 4; ++e) { const float a = fmaxf(v0[e], 0.f), b = fmaxf(v1[e], 0.f); v0[e] = a * a; v1[e] = b * b; }
                    v4u w; w.x = pk2(v0[0], v0[1]); w.y = pk2(v0[2], v0[3]); w.z = pk2(v1[0], v1[1]); w.w = pk2(v1[2], v1[3]);
                    *(v4u*)(ar + colb + bj * 128) = w;
                }
            }
    }
};
struct Epi5 {
    static constexpr bool PERM = false, AFTER_DRAIN = false;
    float* out; float* SS;
    __device__ __forceinline__ void operator()(const f32x4 (&acc)[2][2][4][2], const Unit& u, int wr, int wc, int fr, int fq) const {
        const int row0 = u.pm * 256 + wr * 64 + fr, colb = u.pn * 256 + wc * 32 + 4 * fq;
#pragma unroll
        for (int ai = 0; ai < 2; ++ai)
#pragma unroll
            for (int m = 0; m < 4; ++m) {
                const int row = row0 + ai * 128 + m * 16; float* xo = out + (size_t)row * DM;
                float s = 0.f;
#pragma unroll
                for (int bj = 0; bj < 2; ++bj)
#pragma unroll
                    for (int n = 0; n < 2; ++n) {
                        const int col = colb + bj * 128 + n * 16;
                        const f32x4 v = *(const f32x4*)(xo + col) + acc[ai][bj][m][n];
                        *(f32x4*)(xo + col) = v; s += (v[0] * v[0] + v[1] * v[1]) + (v[2] * v[2] + v[3] * v[3]);
                    }
                s += __shfl_xor(s, 16); s += __shfl_xor(s, 32);
                if (fq == 0) SS[(size_t)(u.pn * 4 + wc) * M + row] = s;
            }
    }
};
#define XB_TMO      128
#define XB_XCNT(j)  (256  + 64 * (j))
#define XB_XSUB(j)  (1280 + 64 * (j))
#define XB_XGEN(j)  (2304 + 64 * (j))
#define XB_TOP      3328
#define XB_TOPGEN   3392
#define XCD_BAR_WORDS 3456
#define XB_SPIN_CAP (1u << 18)

__device__ __forceinline__ unsigned xb_ld(unsigned* p)              { return __hip_atomic_load(p, __ATOMIC_RELAXED, __HIP_MEMORY_SCOPE_AGENT); }
__device__ __forceinline__ unsigned xb_add(unsigned* p, unsigned v) { return __hip_atomic_fetch_add(p, v, __ATOMIC_RELAXED, __HIP_MEMORY_SCOPE_AGENT); }
__device__ __forceinline__ unsigned xb_xcc_id() { return (unsigned)__builtin_amdgcn_s_getreg((3 << 11) | 20) & 0xFu; }
#define XB_SPIN(cond, bar) do { unsigned _sp = 0; while (cond) { __builtin_amdgcn_s_sleep(1); \
    if ((++_sp & 255u) == 0u) { if (xb_ld(&(bar)[XB_TMO])) break; if (_sp > XB_SPIN_CAP) { atomicAdd(&(bar)[XB_TMO], 1u); break; } } } } while (0)

struct XcdBarrier {
    unsigned* bar; unsigned x;
    volatile LAS unsigned* st;
};

__device__ __forceinline__ XcdBarrier xcd_barrier_post(unsigned* bar, volatile LAS unsigned* st) {
    XcdBarrier b; b.bar = bar; b.x = xb_xcc_id(); b.st = st;
    if (threadIdx.x == 0) (void)xb_add(&bar[XB_XCNT(b.x)], 1u);
    return b;
}
__device__ __forceinline__ void xcd_barrier_complete(unsigned* bar, unsigned x, unsigned& nloc, unsigned& nx) {
    const unsigned G = gridDim.x * gridDim.y * gridDim.z;
    unsigned sum, cnt, mine, sp = 0u;
    for (;;) {
        sum = 0u; cnt = 0u; mine = 0u;
#pragma unroll
        for (unsigned j = 0; j < 16; ++j) { const unsigned c = xb_ld(&bar[XB_XCNT(j)]); sum += c; cnt += (c > 0u) ? 1u : 0u; mine = (j == x) ? c : mine; }
        if (sum == G) break;
        __builtin_amdgcn_s_sleep(1);
        if ((++sp & 255u) == 0u) { if (xb_ld(&bar[XB_TMO])) break; if (sp > XB_SPIN_CAP) { atomicAdd(&bar[XB_TMO], 1u); break; } }
    }
    nloc = mine > 0u ? mine : 1u; nx = cnt > 0u ? cnt : 1u;
}

__device__ __forceinline__ void xcd_barrier(const XcdBarrier& b) {
    asm volatile("s_waitcnt vmcnt(0)" ::: "memory");
    __syncthreads();
    if (threadIdx.x == 0) {
        unsigned* bar = b.bar;
        __builtin_amdgcn_s_waitcnt(0);
        unsigned nloc = b.st[0], nx = b.st[1];
        if (nloc == 0u) { xcd_barrier_complete(bar, b.x, nloc, nx); b.st[0] = nloc; b.st[1] = nx; }
        const unsigned old = xb_add(&bar[XB_XSUB(b.x)], 1u);
        const unsigned gen = old / nloc;
        if (old + 1u == (gen + 1u) * nloc) {
            __builtin_amdgcn_fence(__ATOMIC_RELEASE, "agent");
            asm volatile("s_waitcnt vmcnt(0)" ::: "memory");
            const unsigned og = xb_add(&bar[XB_TOP], 1u);
            const unsigned tg = og / nx;
            if (og + 1u == (tg + 1u) * nx) xb_add(&bar[XB_TOPGEN], 1u);
            else XB_SPIN(xb_ld(&bar[XB_TOPGEN]) == tg, bar);
            __builtin_amdgcn_fence(__ATOMIC_ACQUIRE, "agent");
            xb_add(&bar[XB_XGEN(b.x)], 1u);
            asm volatile("s_waitcnt vmcnt(0)" ::: "memory");
        } else {
            XB_SPIN(xb_ld(&bar[XB_XGEN(b.x)]) == gen, bar);
            __builtin_amdgcn_fence(__ATOMIC_ACQUIRE, "agent");
            asm volatile("s_waitcnt vmcnt(0)" ::: "memory");
        }
    }
    __syncthreads();
}

__device__ __forceinline__ void p0_transpose_item(const float* W, const float* rsc, int K, int N, bf16* WT, int row_off, LAS float* scr, int item, int lane) {
    const int nblk = N / 32, kb = item / nblk, nb = item % nblk, k0 = 64 * kb, n0 = 32 * nb;
#pragma unroll 8
    for (int i = 0; i < 32; ++i) { const int kk = 2 * i + (lane >> 5); float w = W[(size_t)(k0 + kk) * N + n0 + (lane & 31)]; if (rsc) w *= rsc[k0 + kk]; scr[kk * 33 + (lane & 31)] = w; }
    LDS_WAIT(); asm volatile("" ::: "memory");
    const int c = lane & 7;
#pragma unroll
    for (int j = 0; j < 4; ++j) { const int n = (lane >> 3) + 8 * j; const LAS float* s = scr + (8 * c) * 33 + n;
        v4u o; o.x = pk2(s[0 * 33], s[1 * 33]); o.y = pk2(s[2 * 33], s[3 * 33]); o.z = pk2(s[4 * 33], s[5 * 33]); o.w = pk2(s[6 * 33], s[7 * 33]);
        *(v4u*)(WT + (size_t)(row_off + n0 + n) * K + k0 + 8 * c) = o; }
    LDS_WAIT(); asm volatile("" ::: "memory");
}
__device__ __forceinline__ void p0_fold_item(const float* w_pool, const float* ps, const float* w_a, bf16* WT, int item, int lane) {
    const int g = item >> 8, rem = item & 255, c0 = (rem >> 4) * 8, n0 = (rem & 15) * 64;
    float a0 = 0.f, a1 = 0.f, a2 = 0.f, a3 = 0.f, a4 = 0.f, a5 = 0.f, a6 = 0.f, a7 = 0.f;
    const float* wp = w_pool + ((size_t)g * 128 + c0) * 128;
    for (int d = 0; d < 128; ++d) {
        const float wa = w_a[(size_t)(g * 128 + d) * DM + n0 + lane] * ps[g * 128 + d];
        a0 += wp[d] * wa; a1 += wp[128 + d] * wa; a2 += wp[256 + d] * wa; a3 += wp[384 + d] * wa;
        a4 += wp[512 + d] * wa; a5 += wp[640 + d] * wa; a6 += wp[768 + d] * wa; a7 += wp[896 + d] * wa;
    }
    v4u o; o.x = pk2(a0, a1); o.y = pk2(a2, a3); o.z = pk2(a4, a5); o.w = pk2(a6, a7);
    *(v4u*)(WT + (size_t)(n0 + lane) * PW + g * 128 + c0) = o;
}

template <int CTRL> __device__ __forceinline__ float dpp_one(float x) { return __builtin_bit_cast(float, __builtin_amdgcn_update_dpp(0x3f800000, __builtin_bit_cast(int, x), CTRL, 0xf, 0xf, false)); }
__device__ __forceinline__ float row_cumprod(float x) { x *= dpp_one<0x111>(x); x *= dpp_one<0x112>(x); x *= dpp_one<0x114>(x); x *= dpp_one<0x118>(x); return x; }
__device__ __forceinline__ float hlo(unsigned u) { return h1((unsigned short)u); }
__device__ __forceinline__ float hhi(unsigned u) { return h1((unsigned short)(u >> 16)); }

__device__ __forceinline__ void scan_pass_a(const bf16* KT, const bf16* VT, bf16* ST, float* nhp, int bh, int vs, int kb, int lane) {
    const int r = lane & 15, q = lane >> 4;
    const bf16* kp = KT + (size_t)bh * NCH * 8192 + (size_t)(q >> 1) * 2048 + (16 * kb + r) * 16 + 8 * (q & 1);
    const bf16* vp = VT + (size_t)bh * NCH * 8192 + (size_t)(q >> 1) * 2048 + (16 * vs + r) * 16 + 8 * (q & 1);
    bf16* sp = ST + (size_t)bh * NCH * 16384 + (size_t)(16 * vs + 4 * q) * 128 + 16 * kb + r;
    f32x4 acc = (f32x4){0.f, 0.f, 0.f, 0.f};
    v4u ka = (v4u){0u, 0u, 0u, 0u}, kbv = ka, va = ka, vb = ka;
    if (q >= 2) { kbv = *(const v4u*)(kp + 4096); vb = *(const v4u*)(vp + 4096); }
#pragma unroll 1
    for (int c = 0; c < NCH; ++c) {
        v4u nka = ka, nkb = kbv, nva = va, nvb = vb;
        if (c + 1 < NCH) { const bf16* kn = kp + (size_t)(c + 1) * 8192; const bf16* vn = vp + (size_t)(c + 1) * 8192;
            nka = *(const v4u*)kn; nkb = *(const v4u*)(kn + 4096); nva = *(const v4u*)vn; nvb = *(const v4u*)(vn + 4096); }
        { bf16* d = sp + (size_t)c * 16384; d[0] = (bf16)f2bf(acc[0]); d[128] = (bf16)f2bf(acc[1]); d[256] = (bf16)f2bf(acc[2]); d[384] = (bf16)f2bf(acc[3]); }
        float k0[8] = {hlo(ka.x), hhi(ka.x), hlo(ka.y), hhi(ka.y), hlo(ka.z), hhi(ka.z), hlo(ka.w), hhi(ka.w)};
        float k1[8] = {hlo(kbv.x), hhi(kbv.x), hlo(kbv.y), hhi(kbv.y), hlo(kbv.z), hhi(kbv.z), hlo(kbv.w), hhi(kbv.w)};
        float ra[8], rb[8]; ra[7] = 1.f; rb[7] = 1.f;
#pragma unroll
        for (int e = 6; e >= 0; --e) { ra[e] = ra[e + 1] * (1.0f - k0[e + 1]); rb[e] = rb[e + 1] * (1.0f - k1[e + 1]); }
        const float pa = ra[0] * (1.0f - k0[0]), pb = rb[0] * (1.0f - k1[0]);
        const float a1 = __shfl_xor(pa, 16), a2 = __shfl_xor(pa, 32), a3 = __shfl_xor(a1, 32);
        const float b1 = __shfl_xor(pb, 16), b2 = __shfl_xor(pb, 32), b3 = __shfl_xor(b1, 32);
        const float ptb = (pb * b1) * (b2 * b3), pta = (pa * a1) * (a2 * a3);
        const float sa = ((q ^ 1) > q ? a1 : 1.f) * ((q ^ 2) > q ? a2 : 1.f) * ((q ^ 3) > q ? a3 : 1.f) * ptb;
        const float sb = ((q ^ 1) > q ? b1 : 1.f) * ((q ^ 2) > q ? b2 : 1.f) * ((q ^ 3) > q ? b3 : 1.f);
        const float dc = pta * ptb;
        unsigned wa[4], wb[4];
#pragma unroll
        for (int e = 0; e < 8; e += 2) { wa[e >> 1] = pk2(k0[e] * ra[e] * sa, k0[e + 1] * ra[e + 1] * sa); wb[e >> 1] = pk2(k1[e] * rb[e] * sb, k1[e + 1] * rb[e + 1] * sb); }
        const bf16x8 kfa = __builtin_bit_cast(bf16x8, (v4u){wa[0], wa[1], wa[2], wa[3]}), kfb = __builtin_bit_cast(bf16x8, (v4u){wb[0], wb[1], wb[2], wb[3]});
        acc = acc * dc;
        acc = __builtin_amdgcn_mfma_f32_16x16x32_bf16(__builtin_bit_cast(bf16x8, va), kfa, acc, 0, 0, 0);
        acc = __builtin_amdgcn_mfma_f32_16x16x32_bf16(__builtin_bit_cast(bf16x8, vb), kfb, acc, 0, 0, 0);
        ka = nka; kbv = nkb; va = nva; vb = nvb;
    }
    *(f32x4*)(nhp + (size_t)bh * 16384 + (size_t)(16 * kb + r) * 128 + 16 * vs + 4 * q) = acc;
}

template <int TH> __device__ __forceinline__ void scan_pass_b(const bf16* Z, const bf16* VT, const bf16* ST, const float* g_onorm, bf16* ON, int bh, int c, int lane) {
    constexpr int NTB = 2 + 2 * TH;
    const int b = bh >> 2, h = bh & 3, r = lane & 15, q = lane >> 4;
    const size_t rowbase = (size_t)b * LP + c * 64 - PADT;
    const bf16* zk = Z + (rowbase + r) * NIN + ZF + h * 128 + 8 * q;
    const bf16* zq = Z + (rowbase + r) * NIN + ZQ + h * 128 + 8 * q;
    bf16x8 Qf[2][4], Kf[NTB][4];
#pragma unroll
    for (int ks = 0; ks < 4; ++ks) {
        float carry[8];
#pragma unroll
        for (int e = 0; e < 8; ++e) carry[e] = 1.f;
#pragma unroll
        for (int tb = 0; tb < NTB; ++tb) {
            const v4u kr = *(const v4u*)(zk + (size_t)tb * 16 * NIN + 32 * ks);
            float kv[8] = {hlo(kr.x), hhi(kr.x), hlo(kr.y), hhi(kr.y), hlo(kr.z), hhi(kr.z), hlo(kr.w), hhi(kr.w)};
            float P[8];
#pragma unroll
            for (int e = 0; e < 8; ++e) { P[e] = row_cumprod(1.0f - kv[e]) * carry[e]; if (tb + 1 < NTB) carry[e] = __shfl(P[e], (lane & 48) | 15); }
            unsigned w[4];
#pragma unroll
            for (int e = 0; e < 8; e += 2) w[e >> 1] = pk2(kv[e] * frcp(P[e]), kv[e + 1] * frcp(P[e + 1]));
            Kf[tb][ks] = __builtin_bit_cast(bf16x8, (v4u){w[0], w[1], w[2], w[3]});
            if (tb >= 2 * TH) {
                const v4u qr = *(const v4u*)(zq + (size_t)tb * 16 * NIN + 32 * ks);
                v4u o; o.x = pk2(bflo(qr.x) * P[0], bfhi(qr.x) * P[1]); o.y = pk2(bflo(qr.y) * P[2], bfhi(qr.y) * P[3]); o.z = pk2(bflo(qr.z) * P[4], bfhi(qr.z) * P[5]); o.w = pk2(bflo(qr.w) * P[6], bfhi(qr.w) * P[7]);
                Qf[tb - 2 * TH][ks] = __builtin_bit_cast(bf16x8, o);
            }
        }
    }
    bf16x8 Af[2][2];
#pragma unroll
    for (int tl = 0; tl < 2; ++tl) { const int tb = 2 * TH + tl;
#pragma unroll
        for (int kk = 0; kk < 2; ++kk) { unsigned w[4] = {0u, 0u, 0u, 0u};
#pragma unroll
            for (int hs = 0; hs < 2; ++hs) { const int sb = 2 * kk + hs;
                if (sb <= tb) { f32x4 d = (f32x4){0.f, 0.f, 0.f, 0.f};
#pragma unroll
                    for (int ks = 0; ks < 4; ++ks) d = __builtin_amdgcn_mfma_f32_16x16x32_bf16(Kf[sb][ks], Qf[tl][ks], d, 0, 0, 0);
                    if (sb == tb) {
#pragma unroll
                        for (int i = 0; i < 4; ++i) d[i] = (4 * q + i <= r) ? d[i] : 0.f; }
                    w[2 * hs] = pk2(d[0], d[1]); w[2 * hs + 1] = pk2(d[2], d[3]); } }
            Af[tl][kk] = __builtin_bit_cast(bf16x8, (v4u){w[0], w[1], w[2], w[3]}); } }
    f32x4 O[2][8];
    const bf16* vt = VT + (size_t)(bh * NCH + c) * 8192 + r * 16 + 4 * q;
    const bf16* st = ST + (size_t)(bh * NCH + c) * 16384 + (size_t)r * 128 + 8 * q;
#pragma unroll
    for (int vb = 0; vb < 8; ++vb) {
        bf16x8 Sf[4], Vf[2];
#pragma unroll
        for (int ks = 0; ks < 4; ++ks) Sf[ks] = *(const bf16x8*)(st + (size_t)vb * 16 * 128 + 32 * ks);
#pragma unroll
        for (int kk = 0; kk < 2; ++kk) { if (kk <= TH) { const v2u lo2 = *(const v2u*)(vt + vb * 256 + (2 * kk) * 2048), hi2 = *(const v2u*)(vt + vb * 256 + (2 * kk + 1) * 2048);
            Vf[kk] = __builtin_bit_cast(bf16x8, (v4u){lo2.x, lo2.y, hi2.x, hi2.y}); } }
#pragma unroll
        for (int tl = 0; tl < 2; ++tl) { f32x4 o = (f32x4){0.f, 0.f, 0.f, 0.f};
#pragma unroll
            for (int ks = 0; ks < 4; ++ks) o = __builtin_amdgcn_mfma_f32_16x16x32_bf16(Sf[ks], Qf[tl][ks], o, 0, 0, 0);
#pragma unroll
            for (int kk = 0; kk < 2; ++kk) if (kk <= TH) o = __builtin_amdgcn_mfma_f32_16x16x32_bf16(Vf[kk], Af[tl][kk], o, 0, 0, 0);
            O[tl][vb] = o; }
    }
#pragma unroll
    for (int tl = 0; tl < 2; ++tl) {
        float ss = 0.f;
#pragma unroll
        for (int vb = 0; vb < 8; ++vb) ss += (O[tl][vb][0] * O[tl][vb][0] + O[tl][vb][1] * O[tl][vb][1]) + (O[tl][vb][2] * O[tl][vb][2] + O[tl][vb][3] * O[tl][vb][3]);
        ss += __shfl_xor(ss, 16); ss += __shfl_xor(ss, 32);
        const float rstd = __builtin_amdgcn_rsqf(ss * (1.0f / 128.0f) + EPS);
        const int t = 16 * (2 * TH + tl) + r;
        const bf16* zo = Z + (rowbase + t) * NIN + ZOG + h * 128 + 4 * q;
        bf16* on = ON + ((size_t)b * SEQ + (size_t)(c - 1) * 64 + t) * PW + h * 128 + 4 * q;
#pragma unroll
        for (int vb = 0; vb < 8; ++vb) { const v2u og = *(const v2u*)(zo + 16 * vb); const f32x4 gn = *(const f32x4*)(g_onorm + 16 * vb + 4 * q); const f32x4 o = O[tl][vb] * rstd;
            v2u w; w.x = pk2(o[0] * gn[0] * bflo(og.x), o[1] * gn[1] * bfhi(og.x)); w.y = pk2(o[2] * gn[2] * bflo(og.y), o[3] * gn[3] * bfhi(og.y));
            *(v2u*)(on + 16 * vb) = w; }
    }
}

__device__ __forceinline__ void sample_hgrn_unit(LAS unsigned char* lds, const bf16* Z, const float* S0, float* Sout, const float* g_onorm, bf16* ON, int s, int h, int tid) {
    LAS float* OP = (LAS float*)lds;
    const size_t row = (size_t)MP + s; const bf16* zr = Z + row * NIN;
    const int v4 = tid & 31, kb = tid >> 5;
    const v2u vw = *(const v2u*)(zr + ZV + h * 128 + v4 * 4); const f32x4 vv = (f32x4){bflo(vw.x), bfhi(vw.x), bflo(vw.y), bfhi(vw.y)};
    f32x4 o4 = (f32x4){0.f, 0.f, 0.f, 0.f};
    const size_t sb = ((size_t)(s * 4 + h) * 128) * 128 + v4 * 4;
#pragma unroll
    for (int i = 0; i < 8; ++i) { const int k = kb + 16 * i; const float kk = h1(zr[ZF + h * 128 + k]), f = 1.0f - kk, qk = bf1(zr[ZQ + h * 128 + k]);
        const f32x4 sn = *(const f32x4*)(S0 + sb + (size_t)k * 128) * f + vv * kk; *(f32x4*)(Sout + sb + (size_t)k * 128) = sn; o4 += sn * qk; }
    *(LAS f32x4*)(OP + kb * 128 + v4 * 4) = o4;
    __syncthreads();
    if (tid < 64) { float oa = 0.f, ob = 0.f;
#pragma unroll
        for (int p = 0; p < 16; ++p) { oa += OP[p * 128 + tid]; ob += OP[p * 128 + 64 + tid]; }
        const float rstd = __builtin_amdgcn_rsqf(wave_sum(oa * oa + ob * ob) * (1.0f / 128.0f) + EPS);
        ON[((size_t)MR + s) * PW + h * 128 + tid] = (bf16)f2bf(oa * rstd * g_onorm[tid] * bf1(zr[ZOG + h * 128 + tid]));
        ON[((size_t)MR + s) * PW + h * 128 + 64 + tid] = (bf16)f2bf(ob * rstd * g_onorm[64 + tid] * bf1(zr[ZOG + h * 128 + 64 + tid])); }
    __syncthreads();
}

__device__ __forceinline__ void skinny_mma(f32x4 (&acc)[4], const bf16* A, int lda, const bf16* Bt, int ldb, int K, int row0, int n0, int wave, int r, int q) {
    const int kw = K >> 3;
    const bf16* ap = A + (size_t)(row0 + r) * lda + wave * kw + 8 * q;
    const bf16* bp = Bt + (size_t)(n0 + r) * ldb + wave * kw + 8 * q;
#pragma unroll 2
    for (int ks = 0; ks < kw; ks += 32) {
        const bf16x8 a = *(const bf16x8*)(ap + ks);
#pragma unroll
        for (int nb = 0; nb < 4; ++nb) { const bf16x8 bb = *(const bf16x8*)(bp + (size_t)nb * 16 * ldb + ks); acc[nb] = __builtin_amdgcn_mfma_f32_16x16x32_bf16(bb, a, acc[nb], 0, 0, 0); }
    }
}
__device__ __forceinline__ void skinny_reduce(LAS unsigned char* lds, f32x4 (&acc)[4], int wave, int lane) {
    LAS float* red = (LAS float*)lds;
#pragma unroll
    for (int nb = 0; nb < 4; ++nb) *(LAS f32x4*)(red + ((wave * 64 + lane) * 16 + nb * 4)) = acc[nb];
    __syncthreads();
    if (wave == 0) {
#pragma unroll
        for (int nb = 0; nb < 4; ++nb) { f32x4 s = (f32x4){0.f, 0.f, 0.f, 0.f};
#pragma unroll
            for (int w = 0; w < 8; ++w) s += *(const LAS f32x4*)(red + ((w * 64 + lane) * 16 + nb * 4));
            acc[nb] = s; } }
    __syncthreads();
}
#define ZERO4(a) do { _Pragma("unroll") for (int z_ = 0; z_ < 4; ++z_) a[z_] = (f32x4){0.f, 0.f, 0.f, 0.f}; } while (0)

struct Args { const float* in[18]; float* out; unsigned char* ws; int ph_lo, ph_hi; };
#ifndef PROBE_DUP
#define PROBE_DUP -1
#endif
#ifndef PROBE_SYNCS
#define PROBE_SYNCS 1
#endif
constexpr int XST_OFF = 131072 + 64;
__global__ void __launch_bounds__(NTHR, 2) hybrid_fwd(Args args) {
    extern __shared__ __attribute__((aligned(16))) unsigned char lds_raw[];
    LAS unsigned char* lds = (LAS unsigned char*)lds_raw;
    const int tid = threadIdx.x, lane = tid & 63, wave = __builtin_amdgcn_readfirstlane(tid >> 6);
    const int G = gridDim.x, bx = blockIdx.x;
    const int gw = bx * NWAVES + wave, NGW = G * NWAVES;
    const int gt = bx * NTHR + tid, NGT = G * NTHR;
    unsigned char* ws = args.ws; float* out = args.out;
    const float *x_prompt = args.in[0], *x_sample = args.in[1], *state_pool = args.in[2], *state_hgrn = args.in[3], *meta = args.in[4], *g_mix = args.in[5], *w_in = args.in[6],
                *w_pool = args.in[7], *pool_scale = args.in[8], *lb_logits = args.in[9], *g_onorm = args.in[10], *w_a = args.in[11], *w_b = args.in[12], *w_out = args.in[13],
                *g_mlp = args.in[14], *w_up = args.in[15], *w_down = args.in[16], *g_final = args.in[17];
    float* LB = (float*)(ws + WS_LB); float* RSTD0 = (float*)(ws + WS_RSTD0); float* SS1 = (float*)(ws + WS_SS1); float* SS2 = (float*)(ws + WS_SS2);
    #ifdef EXP_SWAP
    bf16* KT = (bf16*)(ws + WS_RS); bf16* VT = KT + (size_t)NBH * NCH * 8192;
#else
    bf16* KT = (bf16*)out; bf16* VT = KT + (size_t)NBH * NCH * 8192;
#endif
    bf16 *WIN = (bf16*)(ws + WS_WIN), *WAB = (bf16*)(ws + WS_WAB), *WOUT = (bf16*)(ws + WS_WOUT), *WUP = (bf16*)(ws + WS_WUP), *WDOWN = (bf16*)(ws + WS_WDOWN);
    bf16 *XB = (bf16*)(ws + WS_RA), *PO = (bf16*)(ws + WS_RA), *ON = PO + (size_t)M * PW, *X1B = (bf16*)(ws + WS_RA);
    #ifdef EXP_SWAP
    bf16 *ST = (bf16*)out, *MB = (bf16*)(ws + WS_RS);
#else
    bf16 *ST = (bf16*)(ws + WS_RS), *MB = (bf16*)(ws + WS_RS);
#endif
    bf16 *Z = (bf16*)(ws + WS_Z), *AB = (bf16*)(ws + WS_Z);
    const int lo = args.ph_lo, hi = args.ph_hi;
    if (tid < 2) ((volatile LAS unsigned*)(lds + XST_OFF))[tid] = 0u;
    __syncthreads();
    XcdBarrier bar; bar.bar = (unsigned*)(ws + WS_BAR); bar.x = 0; bar.st = nullptr;
    if (hi - lo > 1) bar = xcd_barrier_post((unsigned*)(ws + WS_BAR), (volatile LAS unsigned*)(lds + XST_OFF));
    if (hi > 1000) cg::this_grid().sync();
#define IN(k) (lo <= (k) && (k) < hi)
#define REP(k) for (int rep_ = 0; rep_ < ((k) == PROBE_DUP ? 2 : 1); ++rep_)
#define SEAM(k) do { if (IN(k) && IN((k) + 1)) for (int s_ = 0; s_ < PROBE_SYNCS; ++s_) xcd_barrier(bar); } while (0)
    const int sr = lane & 15, sq = lane >> 4;

    if (IN(0)) REP(0) {
        LAS float* scr = (LAS float*)(lds + wave * 16384);
        if (gt < PW) LB[gt] = frcp(1.0f + __expf(lb_logits[PW + gt] - lb_logits[gt]));
        constexpr int I_IN = (DM / 64) * (NIN / 32), I_B = (PW / 64) * (DM / 32), I_O = (DM / 64) * (DM / 32), I_UP = (DM / 64) * (FF / 32), I_DN = (FF / 64) * (DM / 32), I_FOLD = 1024;
        constexpr int NITEMS = I_IN + I_B + I_O + I_UP + I_DN + I_FOLD;
        for (int it = gw; it < NITEMS; it += NGW) {
            int r = it;
            if (r < I_IN) { p0_transpose_item(w_in, g_mix, DM, NIN, WIN, 0, scr, r, lane); continue; } r -= I_IN;
            if (r < I_B) { p0_transpose_item(w_b, nullptr, PW, DM, WAB, DM, scr, r, lane); continue; } r -= I_B;
            if (r < I_O) { p0_transpose_item(w_out, nullptr, DM, DM, WOUT, 0, scr, r, lane); continue; } r -= I_O;
            if (r < I_UP) { p0_transpose_item(w_up, g_mlp, DM, FF, WUP, 0, scr, r, lane); continue; } r -= I_UP;
            if (r < I_DN) { p0_transpose_item(w_down, nullptr, FF, DM, WDOWN, 0, scr, r, lane); continue; } r -= I_DN;
            p0_fold_item(w_pool, pool_scale, w_a, WAB, r, lane);
        }
        for (int m = gw; m < M; m += NGW) {
            const f32x4* xr = (const f32x4*)xin_full(x_prompt, x_sample, meta, m) + lane; f32x4 v[4]; float s = 0.f;
#pragma unroll
            for (int j = 0; j < 4; ++j) { v[j] = xr[64 * j]; s += (v[j][0] * v[j][0] + v[j][1] * v[j][1]) + (v[j][2] * v[j][2] + v[j][3] * v[j][3]); }
            s = wave_sum(s); if (lane == 0) RSTD0[m] = __builtin_amdgcn_rsqf(s * (1.0f / DM) + EPS);
            v2u* o8 = (v2u*)(XB + (size_t)m * DM) + lane;
#pragma unroll
            for (int j = 0; j < 4; ++j) { v2u o; o.x = pk2(v[j][0], v[j][1]); o.y = pk2(v[j][2], v[j][3]); o8[64 * j] = o; }
        }
#ifdef EXP_ZERO
        for (size_t i = gt; i < (size_t)NBH * NCH * 8192 * 2 / 8; i += NGT) ((v4u*)KT)[i] = (v4u){0u, 0u, 0u, 0u};
        for (size_t i = gt; i < (size_t)NUNIT * 16384 / 8; i += NGT) ((v4u*)ST)[i] = (v4u){0u, 0u, 0u, 0u};
#endif
        for (int i = gt; i < NSAMP * 14 * (PW / 4); i += NGT) {
            const int s = i / (14 * 128), rem = i - s * (14 * 128), j = rem >> 7, c4 = rem & 127;
            *(f32x4*)(out + OUT_NPS + ((size_t)s * 15 + j) * PW + c4 * 4) = *(const f32x4*)(state_pool + ((size_t)s * 15 + j + 1) * PW + c4 * 4);
        }
    }
    SEAM(0);
    if (IN(1)) REP(1) {
        pg8::Gemm g{XB, WIN, M, NIN, DM}; pg8::StaticOrder S; S.init(M, NIN, G, bx);
        Epi1 E{Z, RSTD0, LB, out, KT, VT};
        pg8::gemm_phase<Epi1, pg8::StaticOrder, true, true>(lds, g, S, E);
    }
    SEAM(1);
    if (IN(2)) REP(2) {
        for (int ba = bx; ba < NBH * 8; ba += G) scan_pass_a(KT, VT, ST, out + OUT_NHP, ba >> 3, ba & 7, wave, lane);
        for (int un = bx; un < NSAMP * 4; un += G)
            sample_hgrn_unit(lds, Z, state_hgrn, out + OUT_NHS, g_onorm, ON, un >> 2, un & 3, tid);
        for (int it = gt; it < MC * 64; it += NGT) {
            const int cr = it >> 6, c8 = it & 63, w = 2 << (c8 >> 4);
            const bf16* U = Z + (size_t)full_of_compact(cr) * NIN + ZU + c8 * 8;
            const v4u cur = *(const v4u*)U;
            const float u0 = bflo(cur.x), u1 = bfhi(cur.x), u2 = bflo(cur.y), u3 = bfhi(cur.y), u4 = bflo(cur.z), u5 = bfhi(cur.z), u6 = bflo(cur.w), u7 = bfhi(cur.w);
            float s0 = u0, s1 = u1, s2 = u2, s3 = u3, s4 = u4, s5 = u5, s6 = u6, s7 = u7;
            if (cr < MR) {
                for (int jj = 1; jj < w; ++jj) { const v4u p = *(const v4u*)(U - (size_t)jj * NIN);
                    s0 += bflo(p.x); s1 += bfhi(p.x); s2 += bflo(p.y); s3 += bfhi(p.y); s4 += bflo(p.z); s5 += bfhi(p.z); s6 += bflo(p.w); s7 += bfhi(p.w); }
            } else { const int sidx = cr - MR;
                for (int jj = 1; jj < w; ++jj) { const float* sp = state_pool + ((size_t)sidx * 15 + (15 - jj)) * PW + c8 * 8; const f32x4 a = *(const f32x4*)sp, bq = *(const f32x4*)(sp + 4);
                    s0 += a[0]; s1 += a[1]; s2 += a[2]; s3 += a[3]; s4 += bq[0]; s5 += bq[1]; s6 += bq[2]; s7 += bq[3]; }
            }
            const float inv = 1.0f / (float)w;
            v4u o; o.x = pk2(s0 * inv - u0, s1 * inv - u1); o.y = pk2(s2 * inv - u2, s3 * inv - u3); o.z = pk2(s4 * inv - u4, s5 * inv - u5); o.w = pk2(s6 * inv - u6, s7 * inv - u7);
            *(v4u*)(PO + (size_t)cr * PW + c8 * 8) = o;
        }
    }
    SEAM(2);
    if (IN(3)) REP(3) {
        for (int un = gw; un < NBH * 64; un += NGW) { const int bh = un >> 6, c = ((un >> 1) & 31) + 1;
            if (un & 1) scan_pass_b<1>(Z, VT, ST, g_onorm, ON, bh, c, lane); else scan_pass_b<0>(Z, VT, ST, g_onorm, ON, bh, c, lane); }
    }
    SEAM(3);
    if (IN(4)) REP(4) {
        { pg8::Gemm g{PO, WAB, 2 * M, 2 * DM, PW}; PairOrder S{G, bx};
          Epi2 E{Z, MB};
          pg8::gemm_phase<Epi2, PairOrder, true, true>(lds, g, S, E); }
        for (int t = bx; t < 128; t += G) { const int row0 = MR + (t >> 4) * 16, n0 = (t & 15) * 64;
            f32x4 ya[4], yb[4]; ZERO4(ya); ZERO4(yb);
            skinny_mma(ya, PO, PW, WAB, PW, PW, row0, n0, wave, sr, sq); skinny_mma(yb, ON, PW, WAB + (size_t)DM * PW, PW, PW, row0, n0, wave, sr, sq);
            skinny_reduce(lds, ya, wave, lane); skinny_reduce(lds, yb, wave, lane);
            if (wave == 0) { const int cr = row0 + sr; const bf16* zr = Z + (size_t)full_of_compact(cr) * NIN;
#pragma unroll
                for (int nb = 0; nb < 4; ++nb) { const int col = n0 + 16 * nb + 4 * sq; const v2u ga = *(const v2u*)(zr + ZGA + col), gb = *(const v2u*)(zr + ZGB + col);
                    v2u o; o.x = pk2(bflo(ga.x) * ya[nb][0] + bflo(gb.x) * yb[nb][0], bfhi(ga.x) * ya[nb][1] + bfhi(gb.x) * yb[nb][1]);
                    o.y = pk2(bflo(ga.y) * ya[nb][2] + bflo(gb.y) * yb[nb][2], bfhi(ga.y) * ya[nb][3] + bfhi(gb.y) * yb[nb][3]);
                    *(v2u*)(MB + (size_t)cr * DM + col) = o; } }
        }
    }
    SEAM(4);
    if (IN(5)) REP(5) {
        { pg8::Gemm g{MB, WOUT, MR, DM, DM}; pg8::StaticOrder S; S.init(MR, DM, G, bx);
          Epi3 E{x_prompt, out, X1B, SS1};
          pg8::gemm_phase<Epi3, pg8::StaticOrder, true, true>(lds, g, S, E); }
        for (int t = bx; t < 128; t += G) { const int row0 = MR + (t >> 4) * 16, n0 = (t & 15) * 64;
            f32x4 acc[4]; ZERO4(acc);
            skinny_mma(acc, MB, DM, WOUT, DM, DM, row0, n0, wave, sr, sq); skinny_reduce(lds, acc, wave, lane);
            if (wave == 0) { const int cr = row0 + sr; const float* xi = x_sample + (size_t)(cr - MR) * DM; float s = 0.f;
#pragma unroll
                for (int nb = 0; nb < 4; ++nb) { const int col = n0 + 16 * nb + 4 * sq; const f32x4 v = *(const f32x4*)(xi + col) + acc[nb];
                    *(f32x4*)(out + (size_t)cr * DM + col) = v; s += (v[0] * v[0] + v[1] * v[1]) + (v[2] * v[2] + v[3] * v[3]);
                    v2u o; o.x = pk2(v[0], v[1]); o.y = pk2(v[2], v[3]); *(v2u*)(X1B + (size_t)cr * DM + col) = o; }
                s += __shfl_xor(s, 16); s += __shfl_xor(s, 32);
                if (sq == 0) SS1[(size_t)(t & 15) * M + cr] = s; }
        }
    }
    SEAM(5);
    if (IN(6)) REP(6) {
        { pg8::Gemm g{X1B, WUP, MR, FF, DM}; pg8::StaticOrder S; S.init(MR, FF, G, bx);
          Epi4 E{AB, SS1};
          pg8::gemm_phase<Epi4, pg8::StaticOrder, true, true>(lds, g, S, E); }
        for (int t = bx; t < 512; t += G) { const int row0 = MR + (t >> 6) * 16, n0 = (t & 63) * 64;
            f32x4 acc[4]; ZERO4(acc);
            skinny_mma(acc, X1B, DM, WUP, DM, DM, row0, n0, wave, sr, sq); skinny_reduce(lds, acc, wave, lane);
            if (wave == 0) { const int cr = row0 + sr; const float rs = rstd_from_parts(SS1, cr);
#pragma unroll
                for (int nb = 0; nb < 4; ++nb) { const int col = n0 + 16 * nb + 4 * sq; f32x4 v = acc[nb] * rs;
#pragma unroll
                    for (int e = 0; e < 4; ++e) { const float a = fmaxf(v[e], 0.f); v[e] = a * a; }
                    v2u o; o.x = pk2(v[0], v[1]); o.y = pk2(v[2], v[3]); *(v2u*)(AB + (size_t)cr * FF + col) = o; } }
        }
    }
    SEAM(6);
    if (IN(7)) REP(7) {
        { pg8::Gemm g{AB, WDOWN, MR, DM, FF}; pg8::StaticOrder S; S.init(MR, DM, G, bx);
          Epi5 E{out, SS2};
          pg8::gemm_phase<Epi5, pg8::StaticOrder, true, true>(lds, g, S, E); }
        for (int t = bx; t < 128; t += G) { const int row0 = MR + (t >> 4) * 16, n0 = (t & 15) * 64;
            f32x4 acc[4]; ZERO4(acc);
            skinny_mma(acc, AB, FF, WDOWN, FF, FF, row0, n0, wave, sr, sq); skinny_reduce(lds, acc, wave, lane);
            if (wave == 0) { const int cr = row0 + sr; float s = 0.f;
#pragma unroll
                for (int nb = 0; nb < 4; ++nb) { const int col = n0 + 16 * nb + 4 * sq; float* xo = out + (size_t)cr * DM + col; const f32x4 v = *(const f32x4*)xo + acc[nb];
                    *(f32x4*)xo = v; s += (v[0] * v[0] + v[1] * v[1]) + (v[2] * v[2] + v[3] * v[3]); }
                s += __shfl_xor(s, 16); s += __shfl_xor(s, 32);
                if (sq == 0) SS2[(size_t)(t & 15) * M + cr] = s; }
        }
    }
    SEAM(7);
    if (IN(8)) REP(8) {
        for (int m = gw; m < MC; m += NGW) {
            const float rs = rstd_from_parts(SS2, m);
            f32x4* xr = (f32x4*)(out + (size_t)m * DM) + lane; const f32x4* gf = (const f32x4*)g_final + lane;
#pragma unroll
            for (int j = 0; j < 4; ++j) xr[64 * j] = xr[64 * j] * rs * gf[64 * j];
        }
    }
#undef IN
#undef SEAM
}

extern "C" void kernel_launch(void* const* d_in, const int* in_sizes, int n_in, void* d_out, int out_size, void* d_ws, size_t ws_size, hipStream_t stream) {
    static int grid = 0;
    if (grid == 0) {
        if (n_in != 18 || (size_t)out_size != OUT_END || ws_size < WS_END) { fprintf(stderr, "kernel_launch: unexpected shapes (n_in %d out %d ws %zu)\n", n_in, out_size, ws_size); grid = -1; return; }
        int dev = 0, cus = 0, per_cu = 0;
        (void)hipGetDevice(&dev); (void)hipDeviceGetAttribute(&cus, hipDeviceAttributeMultiprocessorCount, dev);
        if (hipFuncSetAttribute((const void*)hybrid_fwd, hipFuncAttributeMaxDynamicSharedMemorySize, LDS_BYTES) != hipSuccess) { fprintf(stderr, "kernel_launch: hipFuncSetAttribute failed\n"); grid = -1; return; }
        if (hipOccupancyMaxActiveBlocksPerMultiprocessor(&per_cu, (const void*)hybrid_fwd, NTHR, LDS_BYTES) != hipSuccess || per_cu < 1) { fprintf(stderr, "kernel_launch: occupancy query says %d\n", per_cu); per_cu = 1; }
        (void)hipGetLastError();
        grid = cus * 1;
        if (grid <= 0) grid = 256;
    }
    if (grid < 0) return;
    (void)hipMemsetAsync((unsigned char*)d_ws + WS_BAR, 0, XCD_BAR_WORDS * 4, stream);
#ifdef EXP_MEMSET
    (void)hipMemsetAsync((unsigned char*)d_ws + EXP_MS_LO, EXP_MEMSET, EXP_MS_HI - EXP_MS_LO, stream);
#endif
#ifdef EXP_MEMSET_OUT
    (void)hipMemsetAsync(d_out, EXP_MEMSET_OUT, OUT_END * 4, stream);
#endif
    Args a{};
    for (int i = 0; i < 18; ++i) a.in[i] = (const float*)d_in[i];
    a.out = (float*)d_out; a.ws = (unsigned char*)d_ws;
#if MK_N_LAUNCHES == 1
    a.ph_lo = 0; a.ph_hi = NPHASE;
    void* kargs[] = {&a};
    hipError_t e = hipLaunchCooperativeKernel((const void*)hybrid_fwd, dim3(grid), dim3(NTHR), kargs, LDS_BYTES, stream);
    if (e != hipSuccess) fprintf(stderr, "kernel_launch: cooperative launch failed: %s (grid %d)\n", hipGetErrorString(e), grid);
#else
    for (int p = 0; p < NPHASE; ++p) { a.ph_lo = p; a.ph_hi = p + 1; hipLaunchKernelGGL(hybrid_fwd, dim3(grid), dim3(NTHR), LDS_BYTES, stream, a); }
#endif
}
```

```cpp
#include <hip/hip_runtime.h>
#include <hip/hip_cooperative_groups.h>
#include <cstdio>
#include <cstdint>
namespace cg = cooperative_groups;
namespace pg8 {
#define PG8_LAS __attribute__((address_space(3)))
typedef unsigned short bf16_t;
typedef short bf16x8 __attribute__((ext_vector_type(8)));
typedef float f32x4 __attribute__((ext_vector_type(4)));
typedef unsigned u32x4 __attribute__((ext_vector_type(4)));
constexpr int BM = 256, BK = 64, HALF = 128, HTB = HALF * BK * 2  , STAGE_BYTES = 8 * HTB, NXCD = 8, WGM = 8;

__host__ __device__ __forceinline__ int lds_byte(int r, int c) { const int st = (r >> 4) * 2 + (c >> 5), rr = r & 15, cc = c & 31, ob = rr * 64 + cc * 2; return st * 1024 + (ob ^ (((ob >> 9) & 1) << 5)); }
__host__ __device__ __forceinline__ void stage_rc(int b, int& R, int& C) { const int st = b / 1024, sb = b % 1024, swz = sb ^ (((sb >> 9) & 1) << 5); R = (st >> 1) * 16 + swz / 64; C = (st & 1) * 32 + (swz % 64) / 2; }
__host__ __device__ __forceinline__ int perm32(int rho) { const int n = rho >> 4, i = rho & 15; return 8 * (i >> 2) + 4 * n + (i & 3); }

struct Unit { int pm, pn; };
struct Gemm { const bf16_t* A; const bf16_t* Bt; int M, N, K; };

struct StaticOrder {
    int nM, nN, nwg, G, c;
    __host__ __device__ void init(int M, int N, int G_, int c_) { nM = M / BM; nN = N / BM; nwg = nM * nN; G = G_; c = c_; }
    __host__ __device__ bool next(int i, Unit& u) const {
        const long L = (long)i * G + c; if (L >= nwg) return false;
        int wgid = (int)L; { const int q = nwg / NXCD, r = nwg % NXCD, xcd = wgid % NXCD, off = wgid / NXCD; wgid = (xcd < r ? xcd * (q + 1) : r * (q + 1) + (xcd - r) * q) + off; }
        const int nig = WGM * nN, gid = wgid / nig, fm = gid * WGM, gsz = (nM - fm) < WGM ? (nM - fm) : WGM;
        u.pm = fm + ((wgid % nig) % gsz); u.pn = (wgid % nig) / gsz; return true;
    }
    __device__ __forceinline__ void a_ready(const Unit&) const {}
    __device__ __forceinline__ void done(const Unit&) const {}
};

__device__ __forceinline__ unsigned cvt_pk_bf16(float lo, float hi) { unsigned r; asm volatile("v_cvt_pk_bf16_f32 %0, %1, %2" : "=v"(r) : "v"(lo), "v"(hi)); return r; }
typedef float f32x2 __attribute__((ext_vector_type(2)));
template <class Epi, class Sched, bool ALIGN_EPI = false, bool SP2 = false>
__device__ __forceinline__ void gemm_phase(PG8_LAS unsigned char* lds, const Gemm g, const Sched& S, const Epi& E) {
    const int tid = threadIdx.x, wid = __builtin_amdgcn_readfirstlane(tid >> 6), lane = tid & 63, wr = wid >> 2, wc = wid & 3, fr = lane & 15, fq = lane >> 4;
    const int K = g.K, nt = K / BK;
    unsigned voffA[2], voffB[2];
#pragma unroll
    for (int i = 0; i < 2; ++i) { int R, C; stage_rc(tid * 16 + i * 8192, R, C); const int Rb = Epi::PERM ? ((R & ~31) + perm32(R & 31)) : R;
        voffA[i] = (unsigned)(R * K + C) * 2u; voffB[i] = (unsigned)(Rb * K + C) * 2u; }
    const size_t kstep = (size_t)(BK * 2);
    const size_t hstep = (size_t)HALF * K * 2;
    const size_t tstep = 2 * hstep;
    const unsigned ldsw = (unsigned)wid * 1024u;
    const int aoff = lds_byte(wr * 64 + fr, fq * 8), boff = lds_byte(wc * 32 + fr, fq * 8);
#define PG8_SA(b, h) (((b) * 2 + (h)) * HTB)
#define PG8_SB(b, h) ((4 + (b) * 2 + (h)) * HTB)
#define PG8_STAGE(bufoff, gbase, voff) do { _Pragma("unroll") for (int _i = 0; _i < 2; ++_i) \
        __builtin_amdgcn_global_load_lds((const unsigned*)((const char*)(gbase) + (voff)[_i]), (PG8_LAS unsigned*)(lds + (bufoff) + ldsw + _i * 8192), 16, 0, 0); } while (0)
#define PG8_LDA(dst, b, h) do { _Pragma("unroll") for (int m = 0; m < 4; ++m) _Pragma("unroll") for (int k = 0; k < 2; ++k) dst[m][k] = *(const PG8_LAS bf16x8*)(lds + PG8_SA(b, h) + aoff + m * 2048 + k * 1024); } while (0)
#define PG8_LDB(dst, b, h) do { _Pragma("unroll") for (int n = 0; n < 2; ++n) _Pragma("unroll") for (int k = 0; k < 2; ++k) dst[n][k] = *(const PG8_LAS bf16x8*)(lds + PG8_SB(b, h) + boff + n * 2048 + k * 1024); } while (0)
#define PG8_MMA(ai, bj, At, Bt) do { __builtin_amdgcn_s_setprio(1); _Pragma("unroll") for (int m = 0; m < 4; ++m) _Pragma("unroll") for (int n = 0; n < 2; ++n) _Pragma("unroll") for (int k = 0; k < 2; ++k) \
        acc[ai][bj][m][n] = __builtin_amdgcn_mfma_f32_16x16x32_bf16(Bt[n][k], At[m][k], acc[ai][bj][m][n], 0, 0, 0); __builtin_amdgcn_s_setprio(0); } while (0)
#define PG8_WAIT_V(n) asm volatile("s_waitcnt vmcnt(" #n ")" ::: "memory")
#define PG8_WAIT_L(n) asm volatile("s_waitcnt lgkmcnt(" #n ")" ::: "memory")
#define PG8_BAR __builtin_amdgcn_s_barrier()
#define PG8_SCHED __builtin_amdgcn_sched_barrier(0)
    Unit cur, nxt; int ui = 0;
    if (!S.next(0, cur)) return;
    f32x4 acc[2][2][4][2];
#pragma unroll
    for (int a = 0; a < 2; ++a)
#pragma unroll
        for (int b = 0; b < 2; ++b)
#pragma unroll
            for (int m = 0; m < 4; ++m)
#pragma unroll
                for (int n = 0; n < 2; ++n) acc[a][b][m][n] = (f32x4){0.f, 0.f, 0.f, 0.f};
    bf16x8 At[4][2], B0[2][2], B1[2][2];
    const char* cA = (const char*)g.A + (size_t)cur.pm * tstep; const char* cB = (const char*)g.Bt + (size_t)cur.pn * tstep;
    S.a_ready(cur);
    if constexpr (SP2) {
        PG8_STAGE(PG8_SB(0, 0), cB, voffB); PG8_STAGE(PG8_SB(0, 1), cB + hstep, voffB); PG8_STAGE(PG8_SA(0, 0), cA, voffA); PG8_STAGE(PG8_SA(0, 1), cA + hstep, voffA);
        if (wr == 1) PG8_BAR;
        PG8_WAIT_V(2); PG8_BAR;
        PG8_STAGE(PG8_SB(1, 0), cB + kstep, voffB); PG8_STAGE(PG8_SA(1, 0), cA + kstep, voffA); PG8_STAGE(PG8_SB(1, 1), cB + hstep + kstep, voffB);
        PG8_WAIT_V(6); PG8_BAR;
    } else {
        PG8_STAGE(PG8_SB(0, 0), cB, voffB); PG8_STAGE(PG8_SA(0, 0), cA, voffA); PG8_STAGE(PG8_SB(0, 1), cB + hstep, voffB); PG8_STAGE(PG8_SA(0, 1), cA + hstep, voffA);
        if (wr == 1) PG8_BAR;
        PG8_WAIT_V(4); PG8_BAR;
        PG8_STAGE(PG8_SB(1, 0), cB + kstep, voffB); PG8_STAGE(PG8_SA(1, 0), cA + kstep, voffA); PG8_STAGE(PG8_SB(1, 1), cB + hstep + kstep, voffB);
        PG8_WAIT_V(6); PG8_BAR;
    }
    for (;;) {
        const bool has_next = S.next(ui + 1, nxt);
        const char* nA = has_next ? (const char*)g.A + (size_t)nxt.pm * tstep : cA; const char* nB = has_next ? (const char*)g.Bt + (size_t)nxt.pn * tstep : cB;
        for (int t = 0; t < nt; t += 2) {
            const bool last = (t == nt - 2);
            const char* a1 = cA + (size_t)(t + 1) * kstep;
            const char* a2 = last ? nA : cA + (size_t)(t + 2) * kstep; const char* b2 = last ? nB : cB + (size_t)(t + 2) * kstep;
            const char* a3 = a2 + kstep; const char* b3 = b2 + kstep;
            if (last && has_next) S.a_ready(nxt);
            if constexpr (SP2) {
            PG8_LDB(B0, 0, 0); PG8_LDB(B1, 0, 1); PG8_SCHED; PG8_LDA(At, 0, 0); PG8_STAGE(PG8_SA(1, 1), a1 + hstep, voffA);
            PG8_WAIT_V(8); PG8_WAIT_L(0); PG8_BAR; PG8_MMA(0, 0, At, B0); PG8_MMA(0, 1, At, B1); PG8_BAR; PG8_SCHED;
            PG8_LDA(At, 0, 1); PG8_STAGE(PG8_SB(0, 0), b2, voffB); PG8_STAGE(PG8_SB(0, 1), b2 + hstep, voffB); PG8_STAGE(PG8_SA(0, 0), a2, voffA);
            PG8_WAIT_V(8); PG8_WAIT_L(0); PG8_BAR; PG8_MMA(1, 0, At, B0); PG8_MMA(1, 1, At, B1); PG8_BAR; PG8_SCHED;
            PG8_LDB(B0, 1, 0); PG8_LDB(B1, 1, 1); PG8_SCHED; PG8_LDA(At, 1, 0); PG8_STAGE(PG8_SA(0, 1), a2 + hstep, voffA);
            PG8_WAIT_V(8); PG8_WAIT_L(0); PG8_BAR; PG8_MMA(0, 0, At, B0); PG8_MMA(0, 1, At, B1); PG8_BAR; PG8_SCHED;
            PG8_LDA(At, 1, 1); PG8_STAGE(PG8_SB(1, 0), b3, voffB); PG8_STAGE(PG8_SB(1, 1), b3 + hstep, voffB); PG8_STAGE(PG8_SA(1, 0), a3, voffA);
            PG8_WAIT_V(8); PG8_WAIT_L(0); PG8_BAR; PG8_MMA(1, 0, At, B0); PG8_MMA(1, 1, At, B1); PG8_BAR; PG8_SCHED;
            } else {
            PG8_LDB(B0, 0, 0); PG8_SCHED; PG8_LDA(At, 0, 0); PG8_STAGE(PG8_SA(1, 1), a1 + hstep, voffA);
            PG8_WAIT_L(8); PG8_BAR; PG8_WAIT_L(0); PG8_MMA(0, 0, At, B0); PG8_BAR; PG8_SCHED;
            PG8_LDB(B1, 0, 1); PG8_STAGE(PG8_SB(0, 0), b2, voffB);
            PG8_BAR; PG8_WAIT_L(0); PG8_MMA(0, 1, At, B1); PG8_BAR;
            PG8_LDA(At, 0, 1); PG8_STAGE(PG8_SA(0, 0), a2, voffA);
            PG8_BAR; PG8_WAIT_L(0); PG8_MMA(1, 0, At, B0); PG8_BAR; PG8_SCHED;
            PG8_STAGE(PG8_SB(0, 1), b2 + hstep, voffB);
            PG8_WAIT_V(6); PG8_BAR; PG8_MMA(1, 1, At, B1); PG8_BAR;
            PG8_LDB(B0, 1, 0); PG8_SCHED; PG8_LDA(At, 1, 0); PG8_STAGE(PG8_SA(0, 1), a2 + hstep, voffA);
            PG8_WAIT_L(8); PG8_BAR; PG8_WAIT_L(0); PG8_MMA(0, 0, At, B0); PG8_BAR; PG8_SCHED;
            PG8_LDB(B1, 1, 1); PG8_STAGE(PG8_SB(1, 0), b3, voffB);
            PG8_BAR; PG8_WAIT_L(0); PG8_MMA(0, 1, At, B1); PG8_BAR;
            PG8_LDA(At, 1, 1); PG8_STAGE(PG8_SA(1, 0), a3, voffA);
            PG8_BAR; PG8_WAIT_L(0); PG8_MMA(1, 0, At, B0); PG8_BAR; PG8_SCHED;
            PG8_STAGE(PG8_SB(1, 1), b3 + hstep, voffB);
            PG8_WAIT_V(6); PG8_BAR; PG8_MMA(1, 1, At, B1); PG8_BAR;
            }
        }
        if constexpr (ALIGN_EPI) { if (wr == 0) PG8_BAR; }
        if constexpr (!Epi::AFTER_DRAIN) { E(acc, cur, wr, wc, fr, fq); S.done(cur); }
        if (!has_next) break;
#pragma unroll
        for (int a = 0; a < 2; ++a)
#pragma unroll
            for (int b = 0; b < 2; ++b)
#pragma unroll
                for (int m = 0; m < 4; ++m)
#pragma unroll
                    for (int n = 0; n < 2; ++n) acc[a][b][m][n] = (f32x4){0.f, 0.f, 0.f, 0.f};
        cur = nxt; cA = nA; cB = nB; ++ui;
        if constexpr (ALIGN_EPI) { if (wr == 1) PG8_BAR; }
    }
    PG8_WAIT_V(0);
    if constexpr (!ALIGN_EPI) { if (wr == 0) PG8_BAR; }
    PG8_BAR;
    if constexpr (Epi::AFTER_DRAIN) { E.fused(acc, cur, wr, wc, fr, fq, lds, wid, lane); S.done(cur); }
#undef PG8_SA
#undef PG8_SB
#undef PG8_STAGE
#undef PG8_LDA
#undef PG8_LDB
#undef PG8_MMA
#undef PG8_WAIT_V
#undef PG8_WAIT_L
#undef PG8_BAR
#undef PG8_SCHED
}
}

#define GAS __attribute__((address_space(1)))
#define LAS __attribute__((address_space(3)))
typedef unsigned short bf16;
typedef unsigned v4u __attribute__((ext_vector_type(4)));
typedef unsigned v2u __attribute__((ext_vector_type(2)));
typedef float f32x4 __attribute__((ext_vector_type(4)));
typedef short bf16x8 __attribute__((ext_vector_type(8)));
using pg8::Unit;

#ifndef MK_N_LAUNCHES
#define MK_N_LAUNCHES 1
#endif
constexpr int NPHASE = 9;
constexpr int NWAVES = 8, NTHR = 512;
constexpr int DM = 1024, NB = 8, SEQ = 2048, NMETA = 16, LP = SEQ + NMETA, NSAMP = 128;
constexpr int MP = NB * LP, M = MP + NSAMP, NMT = M / 256;
constexpr int MR = NB * SEQ, MC = MR + NSAMP, NRT = MR / 256;
constexpr int NIN = 4608, FF = 4096, PW = 512;
constexpr int NCH = 33, PADT = 48, NBH = 32, NUNIT = NBH * NCH;
constexpr float EPS = 1e-6f;
constexpr int ZU = 0, ZQ = 512, ZF = 1024, ZV = 1536, ZOG = 2048, ZGA = 2560, ZGB = 3584;
constexpr size_t OUT_YP = 0, OUT_YS = (size_t)NB * SEQ * DM, OUT_NPP = OUT_YS + (size_t)NSAMP * DM, OUT_NHP = OUT_NPP + (size_t)NB * 15 * PW,
                 OUT_NPS = OUT_NHP + (size_t)NB * 4 * 16384, OUT_NHS = OUT_NPS + (size_t)NSAMP * 15 * PW, OUT_END = OUT_NHS + (size_t)NSAMP * 4 * 16384;
constexpr size_t MiB = 1u << 20;
constexpr size_t WS_LB = 0, WS_RSTD0 = 64 * 1024, WS_SS1 = 256 * 1024, WS_SS2 = 1536 * 1024, WS_DVEC = 3 * MiB, WS_DS0 = 5 * MiB, WS_BAR = 7 * MiB;
constexpr size_t WS_WIN = 8 * MiB, WS_WAB = 17 * MiB, WS_WOUT = 19 * MiB, WS_WUP = 21 * MiB, WS_WDOWN = 29 * MiB;
constexpr size_t WS_RA = 37 * MiB;
constexpr size_t WS_RS = 70 * MiB;
constexpr size_t WS_Z = 103 * MiB;
constexpr size_t WS_END = 250 * MiB;
static_assert(WS_RA + (size_t)MC * DM * 4 <= WS_Z && WS_RA + (size_t)M * DM * 2 <= WS_RS && WS_RS + (size_t)NUNIT * 32768 <= WS_Z && WS_Z + (size_t)M * NIN * 2 <= WS_END, "ws map");
static_assert(WS_SS1 + 16 * (size_t)M * 4 <= WS_SS2 && WS_SS2 + 16 * (size_t)M * 4 <= WS_DVEC && WS_DVEC + (size_t)NUNIT * 512 <= WS_DS0, "ws small map");
constexpr int LDS_BYTES = 147456;

#define LDS_WAIT() asm volatile("s_waitcnt lgkmcnt(0)" ::: "memory")
__device__ __forceinline__ unsigned f2bf(float f) { unsigned u = __builtin_bit_cast(unsigned, f); return (u + 0x7fffu + ((u >> 16) & 1u)) >> 16; }
typedef float f32x2c __attribute__((ext_vector_type(2)));
typedef __bf16 bf16x2c __attribute__((ext_vector_type(2)));
__device__ __forceinline__ unsigned pk2(float lo, float hi) { const f32x2c v = {lo, hi}; return __builtin_bit_cast(unsigned, __builtin_convertvector(v, bf16x2c)); }
__device__ __forceinline__ float bflo(unsigned u) { return __builtin_bit_cast(float, u << 16); }
__device__ __forceinline__ float bfhi(unsigned u) { return __builtin_bit_cast(float, u & 0xffff0000u); }
__device__ __forceinline__ float bf1(unsigned short u) { return __builtin_bit_cast(float, (unsigned)u << 16); }
__device__ __forceinline__ float h1(unsigned short u) { return (float)__builtin_bit_cast(_Float16, u); }
__device__ __forceinline__ unsigned pkh2(float lo, float hi) { const _Float16 a = (_Float16)lo, b = (_Float16)hi; return (unsigned)__builtin_bit_cast(unsigned short, a) | ((unsigned)__builtin_bit_cast(unsigned short, b) << 16); }
__device__ __forceinline__ float frcp(float x) { return __builtin_amdgcn_rcpf(x); }
__device__ __forceinline__ float sigm(float x) { return frcp(1.0f + __expf(-x)); }
__device__ __forceinline__ float wave_sum(float v) {
#pragma unroll
    for (int o = 1; o < 64; o <<= 1) v += __shfl_xor(v, o);
    return v;
}
__device__ __forceinline__ const float* xin_full(const float* xp, const float* xs, const float* meta, int r) {
    if (r >= MP) return xs + (size_t)(r - MP) * DM;
    const int b = r / LP, t = r - b * LP;
    return t < NMETA ? meta + (size_t)t * DM : xp + ((size_t)b * SEQ + (t - NMETA)) * DM;
}
__device__ __forceinline__ int full_of_compact(int cr) { return cr < MR ? (cr >> 11) * LP + NMETA + (cr & (SEQ - 1)) : cr + (MP - MR); }

struct Epi1 {
    static constexpr bool PERM = true, AFTER_DRAIN = false;
    bf16* Z; const float* rstd0; const float* lb; float* out; bf16* KT; bf16* VT;
    __device__ __forceinline__ void operator()(const f32x4 (&acc)[2][2][4][2], const Unit& u, int wr, int wc, int fr, int fq) const {
        const int row0 = u.pm * 256 + wr * 64 + fr, colb = u.pn * 256 + wc * 32 + 8 * fq;
        const int type = u.pn < 10 ? (u.pn >> 1) : (u.pn < 14 ? 5 : 6);
#pragma unroll
        for (int ai = 0; ai < 2; ++ai)
#pragma unroll
            for (int m = 0; m < 4; ++m) {
                const int row = row0 + ai * 128 + m * 16; const float rs = rstd0[row];
                bf16* zr = Z + (size_t)row * NIN;
                const int b = row / LP, t = row - b * LP;
                float* pdst = nullptr;
                if (type == 0) { if (row >= MP) pdst = out + OUT_NPS + ((size_t)(row - MP) * 15 + 14) * PW; else if (t >= LP - 15) pdst = out + OUT_NPP + ((size_t)b * 15 + (t - (LP - 15))) * PW; }
                const int tv = t + PADT; const size_t tbase = (((size_t)(b * 4) * NCH + (tv >> 6)) * 4 + ((tv >> 4) & 3)) * 2048 + (tv & 15);
#pragma unroll
                for (int bj = 0; bj < 2; ++bj) {
                    const int col = colb + bj * 128;
                    f32x4 v0 = acc[ai][bj][m][0] * rs, v1 = acc[ai][bj][m][1] * rs; v4u w;
                    if (type == 0 || type == 3) {
                        if (pdst) { *(f32x4*)(pdst + col) = v0; *(f32x4*)(pdst + col + 4) = v1; }
                        w.x = pk2(v0[0], v0[1]); w.y = pk2(v0[2], v0[3]); w.z = pk2(v1[0], v1[1]); w.w = pk2(v1[2], v1[3]);
                    } else if (type == 2) {
                        const f32x4 l0 = *(const f32x4*)(lb + col - ZF), l1 = *(const f32x4*)(lb + col - ZF + 4);
#pragma unroll
                        for (int e = 0; e < 4; ++e) { v0[e] = (1.0f - l0[e]) * sigm(-v0[e]); v1[e] = (1.0f - l1[e]) * sigm(-v1[e]); }
                        w.x = pkh2(v0[0], v0[1]); w.y = pkh2(v0[2], v0[3]); w.z = pkh2(v1[0], v1[1]); w.w = pkh2(v1[2], v1[3]);
                    } else {
#pragma unroll
                        for (int e = 0; e < 4; ++e) { const float s0 = sigm(v0[e]), s1 = sigm(v1[e]); v0[e] = type >= 5 ? s0 : v0[e] * s0; v1[e] = type >= 5 ? s1 : v1[e] * s1; }
                        w.x = pk2(v0[0], v0[1]); w.y = pk2(v0[2], v0[3]); w.z = pk2(v1[0], v1[1]); w.w = pk2(v1[2], v1[3]);
                    }
                    if (type != 3 || row >= MP) *(v4u*)(zr + col) = w;
                    if ((type == 2 || type == 3) && row < MP) {
                        const int hh = 2 * (u.pn & 1) + bj, ch = wc * 32 + 8 * fq;
                        bf16* d = (type == 2 ? KT : VT) + tbase + (size_t)hh * NCH * 8192 + (size_t)ch * 16;
                        d[0] = (bf16)w.x; d[16] = (bf16)(w.x >> 16); d[32] = (bf16)w.y; d[48] = (bf16)(w.y >> 16); d[64] = (bf16)w.z; d[80] = (bf16)(w.z >> 16); d[96] = (bf16)w.w; d[112] = (bf16)(w.w >> 16);
                    }
                }
            }
    }
};
struct PairOrder {
    int G, c;
    __device__ bool next(int i, Unit& u) const { const int L = (i >> 1) * G + c; if (L >= NRT * 4) return false; const int half = i & 1; u.pm = (L >> 2) + half * NMT; u.pn = (L & 3) + half * 4; return true; }
    __device__ __forceinline__ void a_ready(const Unit&) const {}
    __device__ __forceinline__ void done(const Unit&) const {}
};
struct Epi2 {
    static constexpr bool PERM = false, AFTER_DRAIN = false;
    const bf16* Z; bf16* MB;
    __device__ __forceinline__ void operator()(const f32x4 (&acc)[2][2][4][2], const Unit& u, int wr, int wc, int fr, int fq) const {
        const int half = u.pm >= NMT ? 1 : 0;
        const int row0 = (u.pm - half * NMT) * 256 + wr * 64 + fr, colb = (u.pn - half * 4) * 256 + wc * 32 + 4 * fq;
        const int zoff = half ? ZGB : ZGA;
#pragma unroll
        for (int ai = 0; ai < 2; ++ai)
#pragma unroll
            for (int m = 0; m < 4; ++m) {
                const int row = row0 + ai * 128 + m * 16; const bf16* zr = Z + (size_t)full_of_compact(row) * NIN + zoff; bf16* mr = MB + (size_t)row * DM;
#pragma unroll
                for (int bj = 0; bj < 2; ++bj)
#pragma unroll
                    for (int n = 0; n < 2; ++n) {
                        const int col = colb + bj * 128 + n * 16;
                        const v2u g = *(const v2u*)(zr + col); const f32x4 a = acc[ai][bj][m][n];
                        float r0 = bflo(g.x) * a[0], r1 = bfhi(g.x) * a[1], r2 = bflo(g.y) * a[2], r3 = bfhi(g.y) * a[3];
                        if (half) { const v2u t = *(const v2u*)(mr + col); r0 += bflo(t.x); r1 += bfhi(t.x); r2 += bflo(t.y); r3 += bfhi(t.y); }
                        v2u o; o.x = pk2(r0, r1); o.y = pk2(r2, r3); *(v2u*)(mr + col) = o;
                    }
            }
    }
};
struct Epi3 {
    static constexpr bool PERM = false, AFTER_DRAIN = false;
    const float* xp; bf16* X1B; float* SS;
    __device__ __forceinline__ void operator()(const f32x4 (&acc)[2][2][4][2], const Unit& u, int wr, int wc, int fr, int fq) const {
        const int row0 = u.pm * 256 + wr * 64 + fr, colb = u.pn * 256 + wc * 32 + 4 * fq;
#pragma unroll
        for (int ai = 0; ai < 2; ++ai)
#pragma unroll
            for (int m = 0; m < 4; ++m) {
                const int row = row0 + ai * 128 + m * 16; const float* xi = xp + (size_t)row * DM; bf16* xb = X1B + (size_t)row * DM;
                float s = 0.f;
#pragma unroll
                for (int bj = 0; bj < 2; ++bj)
#pragma unroll
                    for (int n = 0; n < 2; ++n) {
                        const int col = colb + bj * 128 + n * 16;
                        const f32x4 v = *(const f32x4*)(xi + col) + acc[ai][bj][m][n];
                        s += (v[0] * v[0] + v[1] * v[1]) + (v[2] * v[2] + v[3] * v[3]);
                        v2u o; o.x = pk2(v[0], v[1]); o.y = pk2(v[2], v[3]); *(v2u*)(xb + col) = o;
                    }
                s += __shfl_xor(s, 16); s += __shfl_xor(s, 32);
                if (fq == 0) SS[(size_t)(u.pn * 4 + wc) * M + row] = s;
            }
    }
};
__device__ __forceinline__ float rstd_from_parts(const float* SS, int row) {
    float s = 0.f;
#pragma unroll
    for (int p = 0; p < 16; ++p) s += SS[(size_t)p * M + row];
    return __builtin_amdgcn_rsqf(s * (1.0f / DM) + EPS);
}
struct Epi4 {
    static constexpr bool PERM = true, AFTER_DRAIN = false;
    bf16* AB; const float* SS;
    __device__ __forceinline__ void operator()(const f32x4 (&acc)[2][2][4][2], const Unit& u, int wr, int wc, int fr, int fq) const {
        const int row0 = u.pm * 256 + wr * 64 + fr, colb = u.pn * 256 + wc * 32 + 8 * fq;
#pragma unroll
        for (int ai = 0; ai < 2; ++ai)
#pragma unroll
            for (int m = 0; m < 4; ++m) {
                const int row = row0 + ai * 128 + m * 16; const float rs = rstd_from_parts(SS, row); bf16* ar = AB + (size_t)row * FF;
#pragma unroll
                for (int bj = 0; bj < 2; ++bj) {
                    f32x4 v0 = acc[ai][bj][m][0] * rs, v1 = acc[ai][bj][m][1] * rs;
#pragma unroll
                    for (int e = 0; e < 4; ++e) { const float a = fmaxf(v0[e], 0.f), b = fmaxf(v1[e], 0.f); v0[e] = a * a; v1[e] = b * b; }
                    v4u w; w.x = pk2(v0[0], v0[1]); w.y = pk2(v0[2], v0[3]); w.z = pk2(v1[0], v1[1]); w.w = pk2(v1[2], v1[3]);
                    *(v4u*)(ar + colb + bj * 128) = w;
                }
            }
    }
};
struct Epi5 {
    static constexpr bool PERM = false, AFTER_DRAIN = false;
    const bf16* X1B; float* X2; float* SS;
    __device__ __forceinline__ void operator()(const f32x4 (&acc)[2][2][4][2], const Unit& u, int wr, int wc, int fr, int fq) const {
        const int row0 = u.pm * 256 + wr * 64 + fr, colb = u.pn * 256 + wc * 32 + 4 * fq;
#pragma unroll
        for (int ai = 0; ai < 2; ++ai)
#pragma unroll
            for (int m = 0; m < 4; ++m) {
                const int row = row0 + ai * 128 + m * 16; const bf16* xo = X1B + (size_t)row * DM; float* x2 = X2 + (size_t)row * DM;
                float s = 0.f;
#pragma unroll
                for (int bj = 0; bj < 2; ++bj)
#pragma unroll
                    for (int n = 0; n < 2; ++n) {
                        const int col = colb + bj * 128 + n * 16;
                        const v2u xw = *(const v2u*)(xo + col); const f32x4 v = (f32x4){bflo(xw.x), bfhi(xw.x), bflo(xw.y), bfhi(xw.y)} + acc[ai][bj][m][n];
                        *(f32x4*)(x2 + col) = v; s += (v[0] * v[0] + v[1] * v[1]) + (v[2] * v[2] + v[3] * v[3]);
                    }
                s += __shfl_xor(s, 16); s += __shfl_xor(s, 32);
                if (fq == 0) SS[(size_t)(u.pn * 4 + wc) * M + row] = s;
            }
    }
};
#define XB_TMO      128
#define XB_XCNT(j)  (256  + 64 * (j))
#define XB_XSUB(j)  (1280 + 64 * (j))
#define XB_XGEN(j)  (2304 + 64 * (j))
#define XB_TOP      3328
#define XB_TOPGEN   3392
#define XCD_BAR_WORDS 3456
#define XB_SPIN_CAP (1u << 18)

__device__ __forceinline__ unsigned xb_ld(unsigned* p)              { return __hip_atomic_load(p, __ATOMIC_RELAXED, __HIP_MEMORY_SCOPE_AGENT); }
__device__ __forceinline__ unsigned xb_add(unsigned* p, unsigned v) { return __hip_atomic_fetch_add(p, v, __ATOMIC_RELAXED, __HIP_MEMORY_SCOPE_AGENT); }
__device__ __forceinline__ unsigned xb_xcc_id() { return (unsigned)__builtin_amdgcn_s_getreg((3 << 11) | 20) & 0xFu; }
#define XB_SPIN(cond, bar) do { unsigned _sp = 0; while (cond) { __builtin_amdgcn_s_sleep(1); \
    if ((++_sp & 255u) == 0u) { if (xb_ld(&(bar)[XB_TMO])) break; if (_sp > XB_SPIN_CAP) { atomicAdd(&(bar)[XB_TMO], 1u); break; } } } } while (0)

struct XcdBarrier {
    unsigned* bar; unsigned x;
    volatile LAS unsigned* st;
};

__device__ __forceinline__ XcdBarrier xcd_barrier_post(unsigned* bar, volatile LAS unsigned* st) {
    XcdBarrier b; b.bar = bar; b.x = xb_xcc_id(); b.st = st;
    if (threadIdx.x == 0) (void)xb_add(&bar[XB_XCNT(b.x)], 1u);
    return b;
}
__device__ __forceinline__ void xcd_barrier_complete(unsigned* bar, unsigned x, unsigned& nloc, unsigned& nx) {
    const unsigned G = gridDim.x * gridDim.y * gridDim.z;
    unsigned sum, cnt, mine, sp = 0u;
    for (;;) {
        sum = 0u; cnt = 0u; mine = 0u;
#pragma unroll
        for (unsigned j = 0; j < 16; ++j) { const unsigned c = xb_ld(&bar[XB_XCNT(j)]); sum += c; cnt += (c > 0u) ? 1u : 0u; mine = (j == x) ? c : mine; }
        if (sum == G) break;
        __builtin_amdgcn_s_sleep(1);
        if ((++sp & 255u) == 0u) { if (xb_ld(&bar[XB_TMO])) break; if (sp > XB_SPIN_CAP) { atomicAdd(&bar[XB_TMO], 1u); break; } }
    }
    nloc = mine > 0u ? mine : 1u; nx = cnt > 0u ? cnt : 1u;
}

__device__ __forceinline__ void xcd_barrier(const XcdBarrier& b) {
    asm volatile("s_waitcnt vmcnt(0)" ::: "memory");
    __syncthreads();
    if (threadIdx.x == 0) {
        unsigned* bar = b.bar;
        __builtin_amdgcn_s_waitcnt(0);
        unsigned nloc = b.st[0], nx = b.st[1];
        if (nloc == 0u) { xcd_barrier_complete(bar, b.x, nloc, nx); b.st[0] = nloc; b.st[1] = nx; }
        const unsigned old = xb_add(&bar[XB_XSUB(b.x)], 1u);
        const unsigned gen = old / nloc;
        if (old + 1u == (gen + 1u) * nloc) {
            __builtin_amdgcn_fence(__ATOMIC_RELEASE, "agent");
            asm volatile("s_waitcnt vmcnt(0)" ::: "memory");
            const unsigned og = xb_add(&bar[XB_TOP], 1u);
            const unsigned tg = og / nx;
            if (og + 1u == (tg + 1u) * nx) xb_add(&bar[XB_TOPGEN], 1u);
            else XB_SPIN(xb_ld(&bar[XB_TOPGEN]) == tg, bar);
            __builtin_amdgcn_fence(__ATOMIC_ACQUIRE, "agent");
            xb_add(&bar[XB_XGEN(b.x)], 1u);
            asm volatile("s_waitcnt vmcnt(0)" ::: "memory");
        } else {
            XB_SPIN(xb_ld(&bar[XB_XGEN(b.x)]) == gen, bar);
            __builtin_amdgcn_fence(__ATOMIC_ACQUIRE, "agent");
            asm volatile("s_waitcnt vmcnt(0)" ::: "memory");
        }
    }
    __syncthreads();
}

__device__ __forceinline__ void p0_transpose_item(const float* W, const float* rsc, int K, int N, bf16* WT, int row_off, LAS float* scr, int item, int lane) {
    const int nblk = N / 32, kb = item / nblk, nb = item % nblk, k0 = 64 * kb, n0 = 32 * nb;
#pragma unroll 8
    for (int i = 0; i < 32; ++i) { const int kk = 2 * i + (lane >> 5); float w = W[(size_t)(k0 + kk) * N + n0 + (lane & 31)]; if (rsc) w *= rsc[k0 + kk]; scr[kk * 33 + (lane & 31)] = w; }
    LDS_WAIT(); asm volatile("" ::: "memory");
    const int c = lane & 7;
#pragma unroll
    for (int j = 0; j < 4; ++j) { const int n = (lane >> 3) + 8 * j; const LAS float* s = scr + (8 * c) * 33 + n;
        v4u o; o.x = pk2(s[0 * 33], s[1 * 33]); o.y = pk2(s[2 * 33], s[3 * 33]); o.z = pk2(s[4 * 33], s[5 * 33]); o.w = pk2(s[6 * 33], s[7 * 33]);
        *(v4u*)(WT + (size_t)(row_off + n0 + n) * K + k0 + 8 * c) = o; }
    LDS_WAIT(); asm volatile("" ::: "memory");
}
__device__ __forceinline__ void p0_fold_item(const float* w_pool, const float* ps, const float* w_a, bf16* WT, int item, int lane) {
    const int g = item >> 8, rem = item & 255, c0 = (rem >> 4) * 8, n0 = (rem & 15) * 64;
    float a0 = 0.f, a1 = 0.f, a2 = 0.f, a3 = 0.f, a4 = 0.f, a5 = 0.f, a6 = 0.f, a7 = 0.f;
    const float* wp = w_pool + ((size_t)g * 128 + c0) * 128;
    for (int d = 0; d < 128; ++d) {
        const float wa = w_a[(size_t)(g * 128 + d) * DM + n0 + lane] * ps[g * 128 + d];
        a0 += wp[d] * wa; a1 += wp[128 + d] * wa; a2 += wp[256 + d] * wa; a3 += wp[384 + d] * wa;
        a4 += wp[512 + d] * wa; a5 += wp[640 + d] * wa; a6 += wp[768 + d] * wa; a7 += wp[896 + d] * wa;
    }
    v4u o; o.x = pk2(a0, a1); o.y = pk2(a2, a3); o.z = pk2(a4, a5); o.w = pk2(a6, a7);
    *(v4u*)(WT + (size_t)(n0 + lane) * PW + g * 128 + c0) = o;
}

template <int CTRL> __device__ __forceinline__ float dpp_one(float x) { return __builtin_bit_cast(float, __builtin_amdgcn_update_dpp(0x3f800000, __builtin_bit_cast(int, x), CTRL, 0xf, 0xf, false)); }
__device__ __forceinline__ float row_cumprod(float x) { x *= dpp_one<0x111>(x); x *= dpp_one<0x112>(x); x *= dpp_one<0x114>(x); x *= dpp_one<0x118>(x); return x; }
__device__ __forceinline__ float hlo(unsigned u) { return h1((unsigned short)u); }
__device__ __forceinline__ float hhi(unsigned u) { return h1((unsigned short)(u >> 16)); }

__device__ __forceinline__ void pass_a_step(f32x4& acc, const v4u ka, const v4u kbv, const v4u va, const v4u vb, bf16* d, int q) {
    d[0] = (bf16)f2bf(acc[0]); d[128] = (bf16)f2bf(acc[1]); d[256] = (bf16)f2bf(acc[2]); d[384] = (bf16)f2bf(acc[3]);
    float k0[8] = {hlo(ka.x), hhi(ka.x), hlo(ka.y), hhi(ka.y), hlo(ka.z), hhi(ka.z), hlo(ka.w), hhi(ka.w)};
    float k1[8] = {hlo(kbv.x), hhi(kbv.x), hlo(kbv.y), hhi(kbv.y), hlo(kbv.z), hhi(kbv.z), hlo(kbv.w), hhi(kbv.w)};
    float ra[8], rb[8]; ra[7] = 1.f; rb[7] = 1.f;
#pragma unroll
    for (int e = 6; e >= 0; --e) { ra[e] = ra[e + 1] * (1.0f - k0[e + 1]); rb[e] = rb[e + 1] * (1.0f - k1[e + 1]); }
    const float pa = ra[0] * (1.0f - k0[0]), pb = rb[0] * (1.0f - k1[0]);
    const float a1 = __shfl_xor(pa, 16), a2 = __shfl_xor(pa, 32), a3 = __shfl_xor(a1, 32);
    const float b1 = __shfl_xor(pb, 16), b2 = __shfl_xor(pb, 32), b3 = __shfl_xor(b1, 32);
    const float ptb = (pb * b1) * (b2 * b3), pta = (pa * a1) * (a2 * a3);
    const float sa = ((q ^ 1) > q ? a1 : 1.f) * ((q ^ 2) > q ? a2 : 1.f) * ((q ^ 3) > q ? a3 : 1.f) * ptb;
    const float sb = ((q ^ 1) > q ? b1 : 1.f) * ((q ^ 2) > q ? b2 : 1.f) * ((q ^ 3) > q ? b3 : 1.f);
    const float dc = pta * ptb;
    unsigned wa[4], wb[4];
#pragma unroll
    for (int e = 0; e < 8; e += 2) { wa[e >> 1] = pk2(k0[e] * ra[e] * sa, k0[e + 1] * ra[e + 1] * sa); wb[e >> 1] = pk2(k1[e] * rb[e] * sb, k1[e + 1] * rb[e + 1] * sb); }
    const bf16x8 kfa = __builtin_bit_cast(bf16x8, (v4u){wa[0], wa[1], wa[2], wa[3]}), kfb = __builtin_bit_cast(bf16x8, (v4u){wb[0], wb[1], wb[2], wb[3]});
    acc = acc * dc;
    acc = __builtin_amdgcn_mfma_f32_16x16x32_bf16(__builtin_bit_cast(bf16x8, va), kfa, acc, 0, 0, 0);
    acc = __builtin_amdgcn_mfma_f32_16x16x32_bf16(__builtin_bit_cast(bf16x8, vb), kfb, acc, 0, 0, 0);
}
__device__ __forceinline__ void scan_pass_a(const bf16* KT, const bf16* VT, bf16* ST, float* nhp, int bh, int vs, int kb, int lane) {
    const int r = lane & 15, q = lane >> 4;
    const bf16* kp = KT + (size_t)bh * NCH * 8192 + (size_t)(q >> 1) * 2048 + (16 * kb + r) * 16 + 8 * (q & 1);
    const bf16* vp = VT + (size_t)bh * NCH * 8192 + (size_t)(q >> 1) * 2048 + (16 * vs + r) * 16 + 8 * (q & 1);
    bf16* sp = ST + (size_t)bh * NCH * 16384 + (size_t)(16 * vs + 4 * q) * 128 + 16 * kb + r;
    f32x4 acc = (f32x4){0.f, 0.f, 0.f, 0.f};
    const v4u zz = (v4u){0u, 0u, 0u, 0u};
    v4u k0b = zz, v0b = zz;
    if (q >= 2) { k0b = *(const v4u*)(kp + 4096); v0b = *(const v4u*)(vp + 4096); }
    v4u KA[4], KB[4], VA[4], VB[4];
#pragma unroll
    for (int u = 0; u < 4; ++u) { const bf16* kn = kp + (size_t)(1 + u) * 8192; const bf16* vn = vp + (size_t)(1 + u) * 8192;
        KA[u] = *(const v4u*)kn; KB[u] = *(const v4u*)(kn + 4096); VA[u] = *(const v4u*)vn; VB[u] = *(const v4u*)(vn + 4096); }
    pass_a_step(acc, zz, k0b, zz, v0b, sp, q);
#pragma unroll 1
    for (int g = 0; g < 8; ++g) {
#pragma unroll
        for (int u = 0; u < 4; ++u) { const int c = 1 + 4 * g + u;
            pass_a_step(acc, KA[u], KB[u], VA[u], VB[u], sp + (size_t)c * 16384, q);
            if (g < 7) { const bf16* kn = kp + (size_t)(c + 4) * 8192; const bf16* vn = vp + (size_t)(c + 4) * 8192;
                KA[u] = *(const v4u*)kn; KB[u] = *(const v4u*)(kn + 4096); VA[u] = *(const v4u*)vn; VB[u] = *(const v4u*)(vn + 4096); } }
    }
    *(f32x4*)(nhp + (size_t)bh * 16384 + (size_t)(16 * kb + r) * 128 + 16 * vs + 4 * q) = acc;
}

template <int TH> __device__ __forceinline__ void scan_pass_b(const bf16* Z, const bf16* VT, const bf16* ST, const float* g_onorm, bf16* ON, int bh, int c, int lane) {
    constexpr int NTB = 2 + 2 * TH;
    const int b = bh >> 2, h = bh & 3, r = lane & 15, q = lane >> 4;
    const size_t rowbase = (size_t)b * LP + c * 64 - PADT;
    const bf16* zk = Z + (rowbase + r) * NIN + ZF + h * 128 + 8 * q;
    const bf16* zq = Z + (rowbase + r) * NIN + ZQ + h * 128 + 8 * q;
    bf16x8 Qf[2][4], Kf[NTB][4];
#pragma unroll
    for (int ks = 0; ks < 4; ++ks) {
        float carry[8];
#pragma unroll
        for (int e = 0; e < 8; ++e) carry[e] = 1.f;
#pragma unroll
        for (int tb = 0; tb < NTB; ++tb) {
            const v4u kr = *(const v4u*)(zk + (size_t)tb * 16 * NIN + 32 * ks);
            float kv[8] = {hlo(kr.x), hhi(kr.x), hlo(kr.y), hhi(kr.y), hlo(kr.z), hhi(kr.z), hlo(kr.w), hhi(kr.w)};
            float P[8];
#pragma unroll
            for (int e = 0; e < 8; ++e) { P[e] = row_cumprod(1.0f - kv[e]) * carry[e]; if (tb + 1 < NTB) carry[e] = __shfl(P[e], (lane & 48) | 15); }
            unsigned w[4];
#pragma unroll
            for (int e = 0; e < 8; e += 2) w[e >> 1] = pk2(kv[e] * frcp(P[e]), kv[e + 1] * frcp(P[e + 1]));
            Kf[tb][ks] = __builtin_bit_cast(bf16x8, (v4u){w[0], w[1], w[2], w[3]});
            if (tb >= 2 * TH) {
                const v4u qr = *(const v4u*)(zq + (size_t)tb * 16 * NIN + 32 * ks);
                v4u o; o.x = pk2(bflo(qr.x) * P[0], bfhi(qr.x) * P[1]); o.y = pk2(bflo(qr.y) * P[2], bfhi(qr.y) * P[3]); o.z = pk2(bflo(qr.z) * P[4], bfhi(qr.z) * P[5]); o.w = pk2(bflo(qr.w) * P[6], bfhi(qr.w) * P[7]);
                Qf[tb - 2 * TH][ks] = __builtin_bit_cast(bf16x8, o);
            }
        }
    }
    bf16x8 Af[2][2];
#pragma unroll
    for (int tl = 0; tl < 2; ++tl) { const int tb = 2 * TH + tl;
#pragma unroll
        for (int kk = 0; kk < 2; ++kk) { unsigned w[4] = {0u, 0u, 0u, 0u};
#pragma unroll
            for (int hs = 0; hs < 2; ++hs) { const int sb = 2 * kk + hs;
                if (sb <= tb) { f32x4 d = (f32x4){0.f, 0.f, 0.f, 0.f};
#pragma unroll
                    for (int ks = 0; ks < 4; ++ks) d = __builtin_amdgcn_mfma_f32_16x16x32_bf16(Kf[sb][ks], Qf[tl][ks], d, 0, 0, 0);
                    if (sb == tb) {
#pragma unroll
                        for (int i = 0; i < 4; ++i) d[i] = (4 * q + i <= r) ? d[i] : 0.f; }
                    w[2 * hs] = pk2(d[0], d[1]); w[2 * hs + 1] = pk2(d[2], d[3]); } }
            Af[tl][kk] = __builtin_bit_cast(bf16x8, (v4u){w[0], w[1], w[2], w[3]}); } }
    f32x4 O[2][8];
    const bf16* vt = VT + (size_t)(bh * NCH + c) * 8192 + r * 16 + 4 * q;
    const bf16* st = ST + (size_t)(bh * NCH + c) * 16384 + (size_t)r * 128 + 8 * q;
#pragma unroll
    for (int vb = 0; vb < 8; ++vb) {
        bf16x8 Sf[4], Vf[2];
#pragma unroll
        for (int ks = 0; ks < 4; ++ks) Sf[ks] = *(const bf16x8*)(st + (size_t)vb * 16 * 128 + 32 * ks);
#pragma unroll
        for (int kk = 0; kk < 2; ++kk) { if (kk <= TH) { const v2u lo2 = *(const v2u*)(vt + vb * 256 + (2 * kk) * 2048), hi2 = *(const v2u*)(vt + vb * 256 + (2 * kk + 1) * 2048);
            Vf[kk] = __builtin_bit_cast(bf16x8, (v4u){lo2.x, lo2.y, hi2.x, hi2.y}); } }
#pragma unroll
        for (int tl = 0; tl < 2; ++tl) { f32x4 o = (f32x4){0.f, 0.f, 0.f, 0.f};
#pragma unroll
            for (int ks = 0; ks < 4; ++ks) o = __builtin_amdgcn_mfma_f32_16x16x32_bf16(Sf[ks], Qf[tl][ks], o, 0, 0, 0);
#pragma unroll
            for (int kk = 0; kk < 2; ++kk) if (kk <= TH) o = __builtin_amdgcn_mfma_f32_16x16x32_bf16(Vf[kk], Af[tl][kk], o, 0, 0, 0);
            O[tl][vb] = o; }
    }
#pragma unroll
    for (int tl = 0; tl < 2; ++tl) {
        float ss = 0.f;
#pragma unroll
        for (int vb = 0; vb < 8; ++vb) ss += (O[tl][vb][0] * O[tl][vb][0] + O[tl][vb][1] * O[tl][vb][1]) + (O[tl][vb][2] * O[tl][vb][2] + O[tl][vb][3] * O[tl][vb][3]);
        ss += __shfl_xor(ss, 16); ss += __shfl_xor(ss, 32);
        const float rstd = __builtin_amdgcn_rsqf(ss * (1.0f / 128.0f) + EPS);
        const int t = 16 * (2 * TH + tl) + r;
        const bf16* zo = Z + (rowbase + t) * NIN + ZOG + h * 128 + 4 * q;
        bf16* on = ON + ((size_t)b * SEQ + (size_t)(c - 1) * 64 + t) * PW + h * 128 + 4 * q;
#pragma unroll
        for (int vb = 0; vb < 8; ++vb) { const v2u og = *(const v2u*)(zo + 16 * vb); const f32x4 gn = *(const f32x4*)(g_onorm + 16 * vb + 4 * q); const f32x4 o = O[tl][vb] * rstd;
            v2u w; w.x = pk2(o[0] * gn[0] * bflo(og.x), o[1] * gn[1] * bfhi(og.x)); w.y = pk2(o[2] * gn[2] * bflo(og.y), o[3] * gn[3] * bfhi(og.y));
            *(v2u*)(on + 16 * vb) = w; }
    }
}

__device__ __forceinline__ void sample_hgrn_unit(LAS unsigned char* lds, const bf16* Z, const float* S0, float* Sout, const float* g_onorm, bf16* ON, int s, int h, int tid) {
    LAS float* OP = (LAS float*)lds;
    const size_t row = (size_t)MP + s; const bf16* zr = Z + row * NIN;
    const int v4 = tid & 31, kb = tid >> 5;
    const v2u vw = *(const v2u*)(zr + ZV + h * 128 + v4 * 4); const f32x4 vv = (f32x4){bflo(vw.x), bfhi(vw.x), bflo(vw.y), bfhi(vw.y)};
    f32x4 o4 = (f32x4){0.f, 0.f, 0.f, 0.f};
    const size_t sb = ((size_t)(s * 4 + h) * 128) * 128 + v4 * 4;
#pragma unroll
    for (int i = 0; i < 8; ++i) { const int k = kb + 16 * i; const float kk = h1(zr[ZF + h * 128 + k]), f = 1.0f - kk, qk = bf1(zr[ZQ + h * 128 + k]);
        const f32x4 sn = *(const f32x4*)(S0 + sb + (size_t)k * 128) * f + vv * kk; *(f32x4*)(Sout + sb + (size_t)k * 128) = sn; o4 += sn * qk; }
    *(LAS f32x4*)(OP + kb * 128 + v4 * 4) = o4;
    __syncthreads();
    if (tid < 64) { float oa = 0.f, ob = 0.f;
#pragma unroll
        for (int p = 0; p < 16; ++p) { oa += OP[p * 128 + tid]; ob += OP[p * 128 + 64 + tid]; }
        const float rstd = __builtin_amdgcn_rsqf(wave_sum(oa * oa + ob * ob) * (1.0f / 128.0f) + EPS);
        ON[((size_t)MR + s) * PW + h * 128 + tid] = (bf16)f2bf(oa * rstd * g_onorm[tid] * bf1(zr[ZOG + h * 128 + tid]));
        ON[((size_t)MR + s) * PW + h * 128 + 64 + tid] = (bf16)f2bf(ob * rstd * g_onorm[64 + tid] * bf1(zr[ZOG + h * 128 + 64 + tid])); }
    __syncthreads();
}

__device__ __forceinline__ void skinny_mma(f32x4 (&acc)[4], const bf16* A, int lda, const bf16* Bt, int ldb, int K, int row0, int n0, int wave, int r, int q) {
    const int kw = K >> 3;
    const bf16* ap = A + (size_t)(row0 + r) * lda + wave * kw + 8 * q;
    const bf16* bp = Bt + (size_t)(n0 + r) * ldb + wave * kw + 8 * q;
#pragma unroll 2
    for (int ks = 0; ks < kw; ks += 32) {
        const bf16x8 a = *(const bf16x8*)(ap + ks);
#pragma unroll
        for (int nb = 0; nb < 4; ++nb) { const bf16x8 bb = *(const bf16x8*)(bp + (size_t)nb * 16 * ldb + ks); acc[nb] = __builtin_amdgcn_mfma_f32_16x16x32_bf16(bb, a, acc[nb], 0, 0, 0); }
    }
}
__device__ __forceinline__ void skinny_reduce(LAS unsigned char* lds, f32x4 (&acc)[4], int wave, int lane) {
    LAS float* red = (LAS float*)lds;
#pragma unroll
    for (int nb = 0; nb < 4; ++nb) *(LAS f32x4*)(red + ((wave * 64 + lane) * 16 + nb * 4)) = acc[nb];
    __syncthreads();
    if (wave == 0) {
#pragma unroll
        for (int nb = 0; nb < 4; ++nb) { f32x4 s = (f32x4){0.f, 0.f, 0.f, 0.f};
#pragma unroll
            for (int w = 0; w < 8; ++w) s += *(const LAS f32x4*)(red + ((w * 64 + lane) * 16 + nb * 4));
            acc[nb] = s; } }
    __syncthreads();
}
#define ZERO4(a) do { _Pragma("unroll") for (int z_ = 0; z_ < 4; ++z_) a[z_] = (f32x4){0.f, 0.f, 0.f, 0.f}; } while (0)

struct Args { const float* in[18]; float* out; unsigned char* ws; int ph_lo, ph_hi; };
#ifndef PROBE_DUP
#define PROBE_DUP -1
#endif
#ifndef PROBE_SYNCS
#define PROBE_SYNCS 1
#endif
constexpr int XST_OFF = 131072 + 64;
__global__ void __launch_bounds__(NTHR, 2) hybrid_fwd(Args args) {
    extern __shared__ __attribute__((aligned(16))) unsigned char lds_raw[];
    LAS unsigned char* lds = (LAS unsigned char*)lds_raw;
    const int tid = threadIdx.x, lane = tid & 63, wave = __builtin_amdgcn_readfirstlane(tid >> 6);
    const int G = gridDim.x, bx = blockIdx.x;
    const int gw = bx * NWAVES + wave, NGW = G * NWAVES;
    const int gt = bx * NTHR + tid, NGT = G * NTHR;
    unsigned char* ws = args.ws; float* out = args.out;
    const float *x_prompt = args.in[0], *x_sample = args.in[1], *state_pool = args.in[2], *state_hgrn = args.in[3], *meta = args.in[4], *g_mix = args.in[5], *w_in = args.in[6],
                *w_pool = args.in[7], *pool_scale = args.in[8], *lb_logits = args.in[9], *g_onorm = args.in[10], *w_a = args.in[11], *w_b = args.in[12], *w_out = args.in[13],
                *g_mlp = args.in[14], *w_up = args.in[15], *w_down = args.in[16], *g_final = args.in[17];
    float* LB = (float*)(ws + WS_LB); float* RSTD0 = (float*)(ws + WS_RSTD0); float* SS1 = (float*)(ws + WS_SS1); float* SS2 = (float*)(ws + WS_SS2);
    #ifdef EXP_SWAP
    bf16* KT = (bf16*)(ws + WS_RS); bf16* VT = KT + (size_t)NBH * NCH * 8192;
#else
    bf16* KT = (bf16*)out; bf16* VT = KT + (size_t)NBH * NCH * 8192;
#endif
    bf16 *WIN = (bf16*)(ws + WS_WIN), *WAB = (bf16*)(ws + WS_WAB), *WOUT = (bf16*)(ws + WS_WOUT), *WUP = (bf16*)(ws + WS_WUP), *WDOWN = (bf16*)(ws + WS_WDOWN);
    bf16 *XB = (bf16*)(ws + WS_RA), *PO = (bf16*)(ws + WS_RA), *ON = PO + (size_t)M * PW, *X1B = (bf16*)(ws + WS_RA);
    #ifdef EXP_SWAP
    bf16 *ST = (bf16*)out, *MB = (bf16*)(ws + WS_RS);
#else
    bf16 *ST = (bf16*)(ws + WS_RS), *MB = (bf16*)(ws + WS_RS);
#endif
    bf16 *Z = (bf16*)(ws + WS_Z), *AB = (bf16*)(ws + WS_Z);
    const int lo = args.ph_lo, hi = args.ph_hi;
    if (tid < 2) ((volatile LAS unsigned*)(lds + XST_OFF))[tid] = 0u;
    __syncthreads();
    XcdBarrier bar; bar.bar = (unsigned*)(ws + WS_BAR); bar.x = 0; bar.st = nullptr;
    if (hi - lo > 1) bar = xcd_barrier_post((unsigned*)(ws + WS_BAR), (volatile LAS unsigned*)(lds + XST_OFF));
    if (hi > 1000) cg::this_grid().sync();
#define IN(k) (lo <= (k) && (k) < hi)
#define REP(k) for (int rep_ = 0; rep_ < ((k) == PROBE_DUP ? 2 : 1); ++rep_)
#define SEAM(k) do { if (IN(k) && IN((k) + 1)) for (int s_ = 0; s_ < PROBE_SYNCS; ++s_) xcd_barrier(bar); } while (0)
    const int sr = lane & 15, sq = lane >> 4;

    if (IN(0)) REP(0) {
        LAS float* scr = (LAS float*)(lds + wave * 16384);
        if (gt < PW) LB[gt] = frcp(1.0f + __expf(lb_logits[PW + gt] - lb_logits[gt]));
        constexpr int I_IN = (DM / 64) * (NIN / 32), I_B = (PW / 64) * (DM / 32), I_O = (DM / 64) * (DM / 32), I_UP = (DM / 64) * (FF / 32), I_DN = (FF / 64) * (DM / 32), I_FOLD = 1024;
        constexpr int NITEMS = I_IN + I_B + I_O + I_UP + I_DN + I_FOLD;
        for (int it = gw; it < NITEMS; it += NGW) {
            int r = it;
            if (r < I_IN) { p0_transpose_item(w_in, g_mix, DM, NIN, WIN, 0, scr, r, lane); continue; } r -= I_IN;
            if (r < I_B) { p0_transpose_item(w_b, nullptr, PW, DM, WAB, DM, scr, r, lane); continue; } r -= I_B;
            if (r < I_O) { p0_transpose_item(w_out, nullptr, DM, DM, WOUT, 0, scr, r, lane); continue; } r -= I_O;
            if (r < I_UP) { p0_transpose_item(w_up, g_mlp, DM, FF, WUP, 0, scr, r, lane); continue; } r -= I_UP;
            if (r < I_DN) { p0_transpose_item(w_down, nullptr, FF, DM, WDOWN, 0, scr, r, lane); continue; } r -= I_DN;
            p0_fold_item(w_pool, pool_scale, w_a, WAB, r, lane);
        }
        for (int m = gw; m < M; m += NGW) {
            const f32x4* xr = (const f32x4*)xin_full(x_prompt, x_sample, meta, m) + lane; f32x4 v[4]; float s = 0.f;
#pragma unroll
            for (int j = 0; j < 4; ++j) { v[j] = xr[64 * j]; s += (v[j][0] * v[j][0] + v[j][1] * v[j][1]) + (v[j][2] * v[j][2] + v[j][3] * v[j][3]); }
            s = wave_sum(s); if (lane == 0) RSTD0[m] = __builtin_amdgcn_rsqf(s * (1.0f / DM) + EPS);
            v2u* o8 = (v2u*)(XB + (size_t)m * DM) + lane;
#pragma unroll
            for (int j = 0; j < 4; ++j) { v2u o; o.x = pk2(v[j][0], v[j][1]); o.y = pk2(v[j][2], v[j][3]); o8[64 * j] = o; }
        }
#ifdef EXP_ZERO
        for (size_t i = gt; i < (size_t)NBH * NCH * 8192 * 2 / 8; i += NGT) ((v4u*)KT)[i] = (v4u){0u, 0u, 0u, 0u};
        for (size_t i = gt; i < (size_t)NUNIT * 16384 / 8; i += NGT) ((v4u*)ST)[i] = (v4u){0u, 0u, 0u, 0u};
#endif
        for (int i = gt; i < NSAMP * 14 * (PW / 4); i += NGT) {
            const int s = i / (14 * 128), rem = i - s * (14 * 128), j = rem >> 7, c4 = rem & 127;
            *(f32x4*)(out + OUT_NPS + ((size_t)s * 15 + j) * PW + c4 * 4) = *(const f32x4*)(state_pool + ((size_t)s * 15 + j + 1) * PW + c4 * 4);
        }
    }
    SEAM(0);
    if (IN(1)) REP(1) {
        pg8::Gemm g{XB, WIN, M, NIN, DM}; pg8::StaticOrder S; S.init(M, NIN, G, bx);
        Epi1 E{Z, RSTD0, LB, out, KT, VT};
        pg8::gemm_phase<Epi1, pg8::StaticOrder, true, true>(lds, g, S, E);
    }
    SEAM(1);
    if (IN(2)) REP(2) {
        REP(12) for (int ba = bx; ba < NBH * 8; ba += G) scan_pass_a(KT, VT, ST, out + OUT_NHP, ba >> 3, ba & 7, wave, lane);
        REP(13) for (int un = bx; un < NSAMP * 4; un += G)
            sample_hgrn_unit(lds, Z, state_hgrn, out + OUT_NHS, g_onorm, ON, un >> 2, un & 3, tid);
        REP(18) for (int it = gt; it < (MR / 16) * 64; it += NGT) {
            const int run = it >> 6, c8 = it & 63, w = 2 << (c8 >> 4), cr0 = run * 16;
            const bf16* U0 = Z + (size_t)full_of_compact(cr0) * NIN + ZU + c8 * 8;
            float s0 = 0.f, s1 = 0.f, s2 = 0.f, s3 = 0.f, s4 = 0.f, s5 = 0.f, s6 = 0.f, s7 = 0.f;
            for (int jj = 1; jj < w; ++jj) { const v4u p = *(const v4u*)(U0 - (size_t)jj * NIN);
                s0 += bflo(p.x); s1 += bfhi(p.x); s2 += bflo(p.y); s3 += bfhi(p.y); s4 += bflo(p.z); s5 += bfhi(p.z); s6 += bflo(p.w); s7 += bfhi(p.w); }
            const float inv = 1.0f / (float)w;
            bf16* po = PO + (size_t)cr0 * PW + c8 * 8;
#pragma unroll 8
            for (int i = 0; i < 16; ++i) {
                const v4u cur = *(const v4u*)(U0 + (size_t)i * NIN), old = *(const v4u*)(U0 + (ptrdiff_t)(i - w + 1) * NIN);
                const float u0 = bflo(cur.x), u1 = bfhi(cur.x), u2 = bflo(cur.y), u3 = bfhi(cur.y), u4 = bflo(cur.z), u5 = bfhi(cur.z), u6 = bflo(cur.w), u7 = bfhi(cur.w);
                s0 += u0; s1 += u1; s2 += u2; s3 += u3; s4 += u4; s5 += u5; s6 += u6; s7 += u7;
                v4u o; o.x = pk2(s0 * inv - u0, s1 * inv - u1); o.y = pk2(s2 * inv - u2, s3 * inv - u3); o.z = pk2(s4 * inv - u4, s5 * inv - u5); o.w = pk2(s6 * inv - u6, s7 * inv - u7);
                *(v4u*)(po + (size_t)i * PW) = o;
                s0 -= bflo(old.x); s1 -= bfhi(old.x); s2 -= bflo(old.y); s3 -= bfhi(old.y); s4 -= bflo(old.z); s5 -= bfhi(old.z); s6 -= bflo(old.w); s7 -= bfhi(old.w);
            }
        }
        for (int it = gt; it < NSAMP * 64; it += NGT) {
            const int sidx = it >> 6, c8 = it & 63, w = 2 << (c8 >> 4), cr = MR + sidx;
            const v4u cur = *(const v4u*)(Z + (size_t)full_of_compact(cr) * NIN + ZU + c8 * 8);
            const float u0 = bflo(cur.x), u1 = bfhi(cur.x), u2 = bflo(cur.y), u3 = bfhi(cur.y), u4 = bflo(cur.z), u5 = bfhi(cur.z), u6 = bflo(cur.w), u7 = bfhi(cur.w);
            float s0 = u0, s1 = u1, s2 = u2, s3 = u3, s4 = u4, s5 = u5, s6 = u6, s7 = u7;
            for (int jj = 1; jj < w; ++jj) { const float* sp = state_pool + ((size_t)sidx * 15 + (15 - jj)) * PW + c8 * 8; const f32x4 a = *(const f32x4*)sp, bq = *(const f32x4*)(sp + 4);
                s0 += a[0]; s1 += a[1]; s2 += a[2]; s3 += a[3]; s4 += bq[0]; s5 += bq[1]; s6 += bq[2]; s7 += bq[3]; }
            const float inv = 1.0f / (float)w;
            v4u o; o.x = pk2(s0 * inv - u0, s1 * inv - u1); o.y = pk2(s2 * inv - u2, s3 * inv - u3); o.z = pk2(s4 * inv - u4, s5 * inv - u5); o.w = pk2(s6 * inv - u6, s7 * inv - u7);
            *(v4u*)(PO + (size_t)cr * PW + c8 * 8) = o;
        }
    }
    SEAM(2);
    if (IN(3)) REP(3) {
        for (int un = gw; un < NBH * 64; un += NGW) { const int bh = un >> 6, c = ((un >> 1) & 31) + 1;
            if (un & 1) scan_pass_b<1>(Z, VT, ST, g_onorm, ON, bh, c, lane); else scan_pass_b<0>(Z, VT, ST, g_onorm, ON, bh, c, lane); }
    }
    SEAM(3);
    if (IN(4)) {
        REP(4) { pg8::Gemm g{PO, WAB, 2 * M, 2 * DM, PW}; PairOrder S{G, bx};
          Epi2 E{Z, MB};
          pg8::gemm_phase<Epi2, PairOrder, true, true>(lds, g, S, E); }
        REP(14) for (int t = bx; t < 128; t += G) { const int row0 = MR + (t >> 4) * 16, n0 = (t & 15) * 64;
            f32x4 ya[4], yb[4]; ZERO4(ya); ZERO4(yb);
            skinny_mma(ya, PO, PW, WAB, PW, PW, row0, n0, wave, sr, sq); skinny_mma(yb, ON, PW, WAB + (size_t)DM * PW, PW, PW, row0, n0, wave, sr, sq);
            skinny_reduce(lds, ya, wave, lane); skinny_reduce(lds, yb, wave, lane);
            if (wave == 0) { const int cr = row0 + sr; const bf16* zr = Z + (size_t)full_of_compact(cr) * NIN;
#pragma unroll
                for (int nb = 0; nb < 4; ++nb) { const int col = n0 + 16 * nb + 4 * sq; const v2u ga = *(const v2u*)(zr + ZGA + col), gb = *(const v2u*)(zr + ZGB + col);
                    v2u o; o.x = pk2(bflo(ga.x) * ya[nb][0] + bflo(gb.x) * yb[nb][0], bfhi(ga.x) * ya[nb][1] + bfhi(gb.x) * yb[nb][1]);
                    o.y = pk2(bflo(ga.y) * ya[nb][2] + bflo(gb.y) * yb[nb][2], bfhi(ga.y) * ya[nb][3] + bfhi(gb.y) * yb[nb][3]);
                    *(v2u*)(MB + (size_t)cr * DM + col) = o; } }
        }
    }
    SEAM(4);
    if (IN(5)) {
        REP(5) { pg8::Gemm g{MB, WOUT, MR, DM, DM}; pg8::StaticOrder S; S.init(MR, DM, G, bx);
          Epi3 E{x_prompt, X1B, SS1};
          pg8::gemm_phase<Epi3, pg8::StaticOrder, true, true>(lds, g, S, E); }
        REP(15) for (int t = bx; t < 128; t += G) { const int row0 = MR + (t >> 4) * 16, n0 = (t & 15) * 64;
            f32x4 acc[4]; ZERO4(acc);
            skinny_mma(acc, MB, DM, WOUT, DM, DM, row0, n0, wave, sr, sq); skinny_reduce(lds, acc, wave, lane);
            if (wave == 0) { const int cr = row0 + sr; const float* xi = x_sample + (size_t)(cr - MR) * DM; float s = 0.f;
#pragma unroll
                for (int nb = 0; nb < 4; ++nb) { const int col = n0 + 16 * nb + 4 * sq; const f32x4 v = *(const f32x4*)(xi + col) + acc[nb];
                    s += (v[0] * v[0] + v[1] * v[1]) + (v[2] * v[2] + v[3] * v[3]);
                    v2u o; o.x = pk2(v[0], v[1]); o.y = pk2(v[2], v[3]); *(v2u*)(X1B + (size_t)cr * DM + col) = o; }
                s += __shfl_xor(s, 16); s += __shfl_xor(s, 32);
                if (sq == 0) SS1[(size_t)(t & 15) * M + cr] = s; }
        }
    }
    SEAM(5);
    if (IN(6)) {
        REP(6) { pg8::Gemm g{X1B, WUP, MR, FF, DM}; pg8::StaticOrder S; S.init(MR, FF, G, bx);
          Epi4 E{AB, SS1};
          pg8::gemm_phase<Epi4, pg8::StaticOrder, true, true>(lds, g, S, E); }
        REP(16) for (int t = bx; t < 512; t += G) { const int row0 = MR + (t >> 6) * 16, n0 = (t & 63) * 64;
            f32x4 acc[4]; ZERO4(acc);
            skinny_mma(acc, X1B, DM, WUP, DM, DM, row0, n0, wave, sr, sq); skinny_reduce(lds, acc, wave, lane);
            if (wave == 0) { const int cr = row0 + sr; const float rs = rstd_from_parts(SS1, cr);
#pragma unroll
                for (int nb = 0; nb < 4; ++nb) { const int col = n0 + 16 * nb + 4 * sq; f32x4 v = acc[nb] * rs;
#pragma unroll
                    for (int e = 0; e < 4; ++e) { const float a = fmaxf(v[e], 0.f); v[e] = a * a; }
                    v2u o; o.x = pk2(v[0], v[1]); o.y = pk2(v[2], v[3]); *(v2u*)(AB + (size_t)cr * FF + col) = o; } }
        }
    }
    SEAM(6);
    if (IN(7)) {
        REP(7) { pg8::Gemm g{AB, WDOWN, MR, DM, FF}; pg8::StaticOrder S; S.init(MR, DM, G, bx);
          Epi5 E{X1B, out, SS2};
          pg8::gemm_phase<Epi5, pg8::StaticOrder, true, true>(lds, g, S, E); }
        REP(17) for (int t = bx; t < 128; t += G) { const int row0 = MR + (t >> 4) * 16, n0 = (t & 15) * 64;
            f32x4 acc[4]; ZERO4(acc);
            skinny_mma(acc, AB, FF, WDOWN, FF, FF, row0, n0, wave, sr, sq); skinny_reduce(lds, acc, wave, lane);
            if (wave == 0) { const int cr = row0 + sr; float s = 0.f;
#pragma unroll
                for (int nb = 0; nb < 4; ++nb) { const int col = n0 + 16 * nb + 4 * sq; const v2u xw = *(const v2u*)(X1B + (size_t)cr * DM + col); const f32x4 v = (f32x4){bflo(xw.x), bfhi(xw.x), bflo(xw.y), bfhi(xw.y)} + acc[nb];
                    *(f32x4*)(out + (size_t)cr * DM + col) = v; s += (v[0] * v[0] + v[1] * v[1]) + (v[2] * v[2] + v[3] * v[3]); }
                s += __shfl_xor(s, 16); s += __shfl_xor(s, 32);
                if (sq == 0) SS2[(size_t)(t & 15) * M + cr] = s; }
        }
    }
    SEAM(7);
    if (IN(8)) REP(8) {
        for (int m = gw; m < MC; m += NGW) {
            const float rs = rstd_from_parts(SS2, m);
            const f32x4* xr = (const f32x4*)(out + (size_t)m * DM) + lane; f32x4* yr = (f32x4*)(out + (size_t)m * DM) + lane; const f32x4* gf = (const f32x4*)g_final + lane;
#pragma unroll
            for (int j = 0; j < 4; ++j) yr[64 * j] = xr[64 * j] * rs * gf[64 * j];
        }
    }
#undef IN
#undef SEAM
}

extern "C" void kernel_launch(void* const* d_in, const int* in_sizes, int n_in, void* d_out, int out_size, void* d_ws, size_t ws_size, hipStream_t stream) {
    static int grid = 0;
    if (grid == 0) {
        if (n_in != 18 || (size_t)out_size != OUT_END || ws_size < WS_END) { fprintf(stderr, "kernel_launch: unexpected shapes (n_in %d out %d ws %zu)\n", n_in, out_size, ws_size); grid = -1; return; }
        int dev = 0, cus = 0, per_cu = 0;
        (void)hipGetDevice(&dev); (void)hipDeviceGetAttribute(&cus, hipDeviceAttributeMultiprocessorCount, dev);
        if (hipFuncSetAttribute((const void*)hybrid_fwd, hipFuncAttributeMaxDynamicSharedMemorySize, LDS_BYTES) != hipSuccess) { fprintf(stderr, "kernel_launch: hipFuncSetAttribute failed\n"); grid = -1; return; }
        if (hipOccupancyMaxActiveBlocksPerMultiprocessor(&per_cu, (const void*)hybrid_fwd, NTHR, LDS_BYTES) != hipSuccess || per_cu < 1) { fprintf(stderr, "kernel_launch: occupancy query says %d\n", per_cu); per_cu = 1; }
        (void)hipGetLastError();
        grid = cus * 1;
        if (grid <= 0) grid = 256;
    }
    if (grid < 0) return;
    (void)hipMemsetAsync((unsigned char*)d_ws + WS_BAR, 0, XCD_BAR_WORDS * 4, stream);
#ifdef EXP_MEMSET
    (void)hipMemsetAsync((unsigned char*)d_ws + EXP_MS_LO, EXP_MEMSET, EXP_MS_HI - EXP_MS_LO, stream);
#endif
#ifdef EXP_MEMSET_OUT
    (void)hipMemsetAsync(d_out, EXP_MEMSET_OUT, OUT_END * 4, stream);
#endif
    Args a{};
    for (int i = 0; i < 18; ++i) a.in[i] = (const float*)d_in[i];
    a.out = (float*)d_out; a.ws = (unsigned char*)d_ws;
#if MK_N_LAUNCHES == 1
    a.ph_lo = 0; a.ph_hi = NPHASE;
    void* kargs[] = {&a};
    hipError_t e = hipLaunchCooperativeKernel((const void*)hybrid_fwd, dim3(grid), dim3(NTHR), kargs, LDS_BYTES, stream);
    if (e != hipSuccess) fprintf(stderr, "kernel_launch: cooperative launch failed: %s (grid %d)\n", hipGetErrorString(e), grid);
#else
    for (int p = 0; p < NPHASE; ++p) { a.ph_lo = p; a.ph_hi = p + 1; hipLaunchKernelGGL(hybrid_fwd, dim3(grid), dim3(NTHR), LDS_BYTES, stream, a); }
#endif
}
```
